# Optimizing an MI355X kernel written in HIP

```python
import jax, jax.numpy as jnp
from jax import lax
import numpy as np

D_MODEL = 2048
BATCH = 16
SEQ = 256
DEPTH = 1
DEC_BATCH = 4
DEC_SEQ = 2048
PAST_LEN = 512

GRID_W = 64
D_MIX = D_MODEL
D_RG = D_MIX // 2
D_CH = D_MIX - D_RG
N_RG_HEADS = 8
RG_HEAD = D_RG // N_RG_HEADS
N_CH_HEADS = 8
CH_HEAD = D_CH // N_CH_HEADS
CHUNK = 128
ROWS_PER_CHUNK = CHUNK // GRID_W
CONV_W = 4
CONV_LEFT = 2
RG_C = 8.0
D_FF = 4 * D_MODEL
N_MOD = 6
D_IN = 2 * D_RG + 2 * D_CH
EPS = 1e-6

kernel_name = "hybrid_rglru_chunkmlp_diffusion_step"


def _rmsnorm(x, g):
    xf = x.astype(jnp.float32)
    y = xf * lax.rsqrt(jnp.mean(xf * xf, axis=-1, keepdims=True) + EPS)
    return (y * g.astype(jnp.float32)).astype(x.dtype)


def _modulation(cond, w_ada, b_ada):
    m = jax.nn.silu(cond) @ w_ada + b_ada
    return jnp.split(m[:, None, :], N_MOD, axis=-1)


def _centred_dwconv(x, w, b):
    L = x.shape[1]
    xp = jnp.pad(x, ((0, 0), (CONV_LEFT, CONV_W - 1 - CONV_LEFT), (0, 0)))
    out = b
    for k in range(CONV_W):
        out = out + w[k] * xp[:, k:k + L]
    return out


def _block_diag(x, w, b):
    B, L, _ = x.shape
    xh = x.reshape(B, L, N_RG_HEADS, RG_HEAD)
    return jnp.einsum('blhi,hij->blhj', xh, w.astype(jnp.float32)).reshape(B, L, D_RG) + b.astype(jnp.float32)


def _linear_scan(a, bx, h0, reverse):
    def step(h, inp):
        a_t, b_t = inp
        h = a_t * h + b_t
        return h, h
    h_last, hs = lax.scan(step, h0, (jnp.swapaxes(a, 0, 1), jnp.swapaxes(bx, 0, 1)), reverse=reverse)
    return jnp.swapaxes(hs, 0, 1), h_last


def _rglru_dir(xf, h0, wa, ba, wi, bi, lam, reverse):
    r = jax.nn.sigmoid(_block_diag(xf, wa, ba))
    i = jax.nn.sigmoid(_block_diag(xf, wi, bi))
    log_a = -RG_C * r * jax.nn.softplus(-lam.astype(jnp.float32))
    a = jnp.exp(log_a)
    mult = jnp.sqrt(jnp.maximum(-jnp.expm1(2.0 * log_a), 0.0))
    return _linear_scan(a, mult * (i * xf), h0, reverse)


def _chunk_sgu(u, v, w_s, b_s, n_chunks):
    B, L, _ = v.shape
    vh = v.reshape(B, n_chunks, CHUNK, N_CH_HEADS, CH_HEAD)
    mixed = jnp.einsum('hpq,bnqhd->bnphd', w_s, vh) + jnp.swapaxes(b_s, 0, 1)[None, None, :, :, None]
    return u * mixed.reshape(B, L, D_CH)


def _layer(x, cond, h0, n_chunks, p):
    shift1, scale1, gate1, shift2, scale2, gate2 = _modulation(cond, p['w_ada'], p['b_ada'])
    h = _rmsnorm(x, p['norm1_g']) * (1.0 + scale1) + shift1
    proj = h @ p['w_in']
    y_rg = proj[..., :D_RG]
    x_rg = proj[..., D_RG:2 * D_RG]
    uv = jax.nn.gelu(proj[..., 2 * D_RG:])
    xc = _centred_dwconv(x_rg, p['conv_w'], p['conv_b']).astype(jnp.float32)
    hf, hf_last = _rglru_dir(xc, h0[:, 0], p['ga_w'][0], p['ga_b'][0], p['gi_w'][0], p['gi_b'][0], p['lam'][0], False)
    hb, hb_last = _rglru_dir(xc, h0[:, 1], p['ga_w'][1], p['ga_b'][1], p['gi_w'][1], p['gi_b'][1], p['lam'][1], True)
    rg_out = jax.nn.gelu(y_rg) * (hf + hb).astype(x.dtype)
    ch_out = _chunk_sgu(uv[..., :D_CH], uv[..., D_CH:], p['sgu_w'], p['sgu_b'], n_chunks)
    mix = jnp.concatenate([rg_out, ch_out], axis=-1) @ p['w_out']
    x = x + gate1 * mix
    h2 = _rmsnorm(x, p['norm2_g']) * (1.0 + scale2) + shift2
    ff = jnp.square(jax.nn.relu(h2 @ p['w_ff1'])) @ p['w_ff2']
    x = x + gate2 * ff
    return x, jnp.stack([hf_last, hb_last], axis=1)


def setup_inputs(seed: int = 0) -> dict:
    key = jax.random.key(seed)
    ks = jax.random.split(key, 24)
    f32 = jnp.float32
    nrm = lambda k, shape, s: jax.random.normal(k, shape, f32) * s
    u = jax.random.uniform(ks[14], (DEPTH, 2, D_RG), f32, 0.9, 0.999)
    s = u ** (1.0 / RG_C)
    lam = jnp.log(s) - jnp.log1p(-s)
    return {
        'x_prompt': nrm(ks[0], (BATCH, SEQ, D_MODEL), 1.0),
        'x_sample': nrm(ks[1], (DEC_BATCH, DEC_SEQ, D_MODEL), 1.0),
        'c': nrm(ks[2], (DEC_BATCH, D_MODEL), 1.0),
        'state_rglru': nrm(ks[3], (DEC_BATCH, DEPTH, 2, D_RG), 0.5),
        'c_ctx': nrm(ks[4], (D_MODEL,), 1.0),
        'norm1_g': 1.0 + nrm(ks[5], (DEPTH, D_MODEL), 0.02),
        'w_ada': nrm(ks[6], (DEPTH, D_MODEL, N_MOD * D_MODEL), 0.5 * D_MODEL ** -0.5),
        'b_ada': nrm(ks[7], (DEPTH, N_MOD * D_MODEL), 0.02),
        'w_in': nrm(ks[8], (DEPTH, D_MODEL, D_IN), D_MODEL ** -0.5),
        'conv_w': nrm(ks[9], (DEPTH, CONV_W, D_RG), CONV_W ** -0.5),
        'conv_b': nrm(ks[10], (DEPTH, D_RG), 0.02),
        'ga_w': nrm(ks[11], (DEPTH, 2, N_RG_HEADS, RG_HEAD, RG_HEAD), RG_HEAD ** -0.5),
        'ga_b': nrm(ks[12], (DEPTH, 2, D_RG), 0.02),
        'gi_w': nrm(ks[13], (DEPTH, 2, N_RG_HEADS, RG_HEAD, RG_HEAD), RG_HEAD ** -0.5),
        'gi_b': nrm(ks[15], (DEPTH, 2, D_RG), 0.02),
        'lru_lambda': lam,
        'sgu_w': nrm(ks[16], (DEPTH, N_CH_HEADS, CHUNK, CHUNK), CHUNK ** -0.5),
        'sgu_b': nrm(ks[17], (DEPTH, N_CH_HEADS, CHUNK), 0.02),
        'w_out': nrm(ks[18], (DEPTH, D_MIX, D_MODEL), D_MIX ** -0.5),
        'norm2_g': 1.0 + nrm(ks[19], (DEPTH, D_MODEL), 0.02),
        'w_ff1': nrm(ks[20], (DEPTH, D_MODEL, D_FF), D_MODEL ** -0.5),
        'w_ff2': nrm(ks[21], (DEPTH, D_FF, D_MODEL), D_FF ** -0.5),
        'final_g': 1.0 + nrm(ks[22], (D_MODEL,), 0.02),
    }


def reference(x_prompt, x_sample, c, state_rglru, c_ctx, norm1_g, w_ada, b_ada, w_in,
              conv_w, conv_b, ga_w, ga_b, gi_w, gi_b, lru_lambda, sgu_w, sgu_b, w_out,
              norm2_g, w_ff1, w_ff2, final_g):
    b_ctx, l_ctx = x_prompt.shape[0], x_prompt.shape[1]
    ctx_chunks = l_ctx // CHUNK
    rows = x_sample.shape[1] // GRID_W
    lat_chunks = rows // ROWS_PER_CHUNK
    cond_ctx = jnp.broadcast_to(c_ctx, (b_ctx, D_MODEL))
    xp = x_prompt
    xs = x_sample
    ctx_states = []
    for l in range(DEPTH):
        p = {'w_ada': w_ada[l], 'b_ada': b_ada[l], 'norm1_g': norm1_g[l], 'w_in': w_in[l],
             'conv_w': conv_w[l], 'conv_b': conv_b[l], 'ga_w': ga_w[l], 'ga_b': ga_b[l],
             'gi_w': gi_w[l], 'gi_b': gi_b[l], 'lam': lru_lambda[l], 'sgu_w': sgu_w[l],
             'sgu_b': sgu_b[l], 'w_out': w_out[l], 'norm2_g': norm2_g[l],
             'w_ff1': w_ff1[l], 'w_ff2': w_ff2[l]}
        h0_ctx = jnp.zeros((b_ctx, 2, D_RG), jnp.float32)
        xp, st = _layer(xp, cond_ctx, h0_ctx, ctx_chunks, p)
        ctx_states.append(st)
        xs, _ = _layer(xs, c, state_rglru[:, l].astype(jnp.float32), lat_chunks, p)
    y_prompt = _rmsnorm(xp, final_g)
    y_sample = _rmsnorm(xs, final_g)
    new_state_rglru = jnp.stack(ctx_states, axis=1).astype(x_prompt.dtype)
    return (y_prompt, y_sample, new_state_rglru)
```

```cpp
#include <hip/hip_runtime.h>
#include <hip/hip_cooperative_groups.h>
#include <cstdio>
#include <cstdint>
namespace cg = cooperative_groups;
namespace pg8 {
#define PG8_LAS __attribute__((address_space(3)))
typedef unsigned short bf16_t;
typedef short bf16x8 __attribute__((ext_vector_type(8)));
typedef float f32x4 __attribute__((ext_vector_type(4)));
typedef unsigned u32x4 __attribute__((ext_vector_type(4)));
constexpr int BM = 256, BK = 64, HALF = 128, HTB = HALF * BK * 2  , STAGE_BYTES = 8 * HTB, NXCD = 8, WGM = 8;

__host__ __device__ __forceinline__ int lds_byte(int r, int c) { const int st = (r >> 4) * 2 + (c >> 5), rr = r & 15, cc = c & 31, ob = rr * 64 + cc * 2; return st * 1024 + (ob ^ (((ob >> 9) & 1) << 5)); }
__host__ __device__ __forceinline__ void stage_rc(int b, int& R, int& C) { const int st = b / 1024, sb = b % 1024, swz = sb ^ (((sb >> 9) & 1) << 5); R = (st >> 1) * 16 + swz / 64; C = (st & 1) * 32 + (swz % 64) / 2; }
__host__ __device__ __forceinline__ int perm32(int rho) { const int n = rho >> 4, i = rho & 15; return 8 * (i >> 2) + 4 * n + (i & 3); }

struct Unit { int pm, pn, k0, nt, part; };
struct Gemm { const bf16_t* A; const bf16_t* Bt; int M, N, K, ld; };

struct StaticOrder {
    int nM, nN, nwg, G, c, ntk;
    __host__ __device__ void init(int M, int N, int K, int G_, int c_) { nM = M / BM; nN = N / BM; nwg = nM * nN; G = G_; c = c_; ntk = K / BK; }
    __host__ __device__ bool next(int i, Unit& u) const {
        const long L = (long)i * G + c; if (L >= nwg) return false;
        int wgid = (int)L; { const int q = nwg / NXCD, r = nwg % NXCD, xcd = wgid % NXCD, off = wgid / NXCD; wgid = (xcd < r ? xcd * (q + 1) : r * (q + 1) + (xcd - r) * q) + off; }
        const int nig = WGM * nN, gid = wgid / nig, fm = gid * WGM, gsz = (nM - fm) < WGM ? (nM - fm) : WGM;
        u.pm = fm + ((wgid % nig) % gsz); u.pn = (wgid % nig) / gsz; u.k0 = 0; u.nt = ntk; u.part = 0; return true;
    }
    __device__ __forceinline__ void a_ready(const Unit&) const {}
    __device__ __forceinline__ void done(const Unit&) const {}
};
__device__ __forceinline__ unsigned cvt_pk_bf16(float lo, float hi) { unsigned r; asm volatile("v_cvt_pk_bf16_f32 %0, %1, %2" : "=v"(r) : "v"(lo), "v"(hi)); return r; }
__device__ __forceinline__ float gelu_tanh(float x) {
    const float u = x * (0.7978845608f + 0.0356774081f * x * x);
    const float e = __builtin_amdgcn_exp2f(-2.885390082f * u);
    return x * __builtin_amdgcn_rcpf(1.0f + e);
}
struct EpiProj {
    static constexpr bool PERM = true, AFTER_DRAIN = false;
    bf16_t* O; int ldc;
    __device__ __forceinline__ void operator()(const f32x4 (&acc)[2][2][4][2], const Unit& u, int wr, int wc, int fr, int fq) const {
        const int row0 = u.pm * BM + wr * 64 + fr, col0 = u.pn * BM + wc * 32 + 8 * fq;
#pragma unroll
        for (int ai = 0; ai < 2; ++ai)
#pragma unroll
            for (int m = 0; m < 4; ++m) { bf16_t* rowp = O + (size_t)(row0 + ai * HALF + m * 16) * ldc + col0;
#pragma unroll
                for (int bj = 0; bj < 2; ++bj) { const f32x4 v0 = acc[ai][bj][m][0], v1 = acc[ai][bj][m][1];
                    u32x4 w; w.x = cvt_pk_bf16(v0[0], v0[1]); w.y = cvt_pk_bf16(v0[2], v0[3]); w.z = cvt_pk_bf16(v1[0], v1[1]); w.w = cvt_pk_bf16(v1[2], v1[3]);
                    *(u32x4*)(rowp + bj * HALF) = w; } }
    }
};
struct EpiRelu2 {
    static constexpr bool PERM = true, AFTER_DRAIN = false;
    bf16_t* O; int ldc;
    __device__ __forceinline__ void operator()(const f32x4 (&acc)[2][2][4][2], const Unit& u, int wr, int wc, int fr, int fq) const {
        const int row0 = u.pm * BM + wr * 64 + fr, col0 = u.pn * BM + wc * 32 + 8 * fq;
#pragma unroll
        for (int ai = 0; ai < 2; ++ai)
#pragma unroll
            for (int m = 0; m < 4; ++m) { bf16_t* rowp = O + (size_t)(row0 + ai * HALF + m * 16) * ldc + col0;
#pragma unroll
                for (int bj = 0; bj < 2; ++bj) { f32x4 v0 = acc[ai][bj][m][0], v1 = acc[ai][bj][m][1];
#pragma unroll
                    for (int j = 0; j < 4; ++j) { const float a = fmaxf(v0[j], 0.f), b = fmaxf(v1[j], 0.f); v0[j] = a * a; v1[j] = b * b; }
                    u32x4 w; w.x = cvt_pk_bf16(v0[0], v0[1]); w.y = cvt_pk_bf16(v0[2], v0[3]); w.z = cvt_pk_bf16(v1[0], v1[1]); w.w = cvt_pk_bf16(v1[2], v1[3]);
                    __builtin_nontemporal_store(w, (u32x4*)(rowp + bj * HALF)); } }
    }
};
struct SplitOrder {
    int G, c, ntk;
    __host__ __device__ void init(int K, int G_, int c_) { G = G_; c = c_; ntk = K / BK; }
    __host__ __device__ bool next(int i, Unit& u) const {
        const long L = (long)i * G + c; if (L >= 512) return false;
        if (L < 256) { const int xcd = (int)L & 7, off = (int)L >> 3;
            u.pm = xcd * 4 + (off & 3); u.pn = off >> 2; u.k0 = 0; u.nt = ntk; u.part = 0; return true; }
        const int hl = (int)L - 256, x = hl & 7, off = hl >> 3, pr = x >> 1, kh = x & 1;
        u.pm = 32 + pr * 4 + (off & 3); u.pn = off >> 2; u.k0 = kh * (ntk / 2) * BK; u.nt = ntk / 2; u.part = kh; return true;
    }
    __device__ __forceinline__ void a_ready(const Unit&) const {}
    __device__ __forceinline__ void done(const Unit&) const {}
};
struct EpiRes {
    static constexpr bool PERM = false, AFTER_DRAIN = false;
    const float* base0; const float* base1; float* out; const float* gate; float* part;
    __device__ __forceinline__ void operator()(const f32x4 (&acc)[2][2][4][2], const Unit& u, int wr, int wc, int fr, int fq) const {
        const int row0 = u.pm * BM + wr * 64 + fr, col0 = u.pn * BM + wc * 32 + 4 * fq;
        const int cond = u.pm < 16 ? 0 : 1 + ((u.pm - 16) >> 3);
        const float* gp = gate + cond * 12288 + col0;
        const float* bb = u.pm < 16 ? base0 + (size_t)row0 * 2048 + col0 : base1 + (size_t)(row0 - 4096) * 2048 + col0;
        float* ob = out + (size_t)row0 * 2048 + col0;
        float* pb = part + ((size_t)row0 - 8192) * 2048 + col0;
        f32x4 gv[2][2];
#pragma unroll
        for (int bj = 0; bj < 2; ++bj)
#pragma unroll
            for (int n = 0; n < 2; ++n) gv[bj][n] = *(const f32x4*)(gp + bj * HALF + n * 16);
#pragma unroll
        for (int ai = 0; ai < 2; ++ai)
#pragma unroll
            for (int m = 0; m < 4; ++m) { const size_t ro = (size_t)(ai * HALF + m * 16) * 2048;
#pragma unroll
                for (int bj = 0; bj < 2; ++bj)
#pragma unroll
                    for (int n = 0; n < 2; ++n) {
                        if (u.part) *(f32x4*)(pb + ro + bj * HALF + n * 16) = gv[bj][n] * acc[ai][bj][m][n];
                        else { const f32x4 b = *(const f32x4*)(bb + ro + bj * HALF + n * 16); *(f32x4*)(ob + ro + bj * HALF + n * 16) = b + gv[bj][n] * acc[ai][bj][m][n]; } }
                asm volatile("" ::: "memory"); }
    }
};
struct EpiDelta {
    static constexpr bool PERM = true, AFTER_DRAIN = false;
    bf16_t* D; bf16_t* Dpart; const float* gate;
    __device__ __forceinline__ void operator()(const f32x4 (&acc)[2][2][4][2], const Unit& u, int wr, int wc, int fr, int fq) const {
        const int row0 = u.pm * BM + wr * 64 + fr, col0 = u.pn * BM + wc * 32 + 8 * fq;
        const int cond = u.pm < 16 ? 0 : 1 + ((u.pm - 16) >> 3);
        const float* gp = gate + cond * 12288 + col0;
        f32x4 g0[2], g1[2];
#pragma unroll
        for (int bj = 0; bj < 2; ++bj) { g0[bj] = *(const f32x4*)(gp + bj * HALF); g1[bj] = *(const f32x4*)(gp + bj * HALF + 4); }
        bf16_t* base = (u.part ? Dpart + ((long)row0 - 8192) * 2048 : D + (long)row0 * 2048) + col0;
#pragma unroll
        for (int ai = 0; ai < 2; ++ai)
#pragma unroll
            for (int m = 0; m < 4; ++m) { bf16_t* rowp = base + (long)(ai * HALF + m * 16) * 2048;
#pragma unroll
                for (int bj = 0; bj < 2; ++bj) { const f32x4 v0 = acc[ai][bj][m][0] * g0[bj], v1 = acc[ai][bj][m][1] * g1[bj];
                    u32x4 w; w.x = cvt_pk_bf16(v0[0], v0[1]); w.y = cvt_pk_bf16(v0[2], v0[3]); w.z = cvt_pk_bf16(v1[0], v1[1]); w.w = cvt_pk_bf16(v1[2], v1[3]);
                    *(u32x4*)(rowp + bj * HALF) = w; } }
    }
};
template <class Epi, class Sched, bool ALIGN_EPI = false, bool SP2 = false>
__device__ __forceinline__ void gemm_phase(PG8_LAS unsigned char* lds, const Gemm g, const Sched& S, const Epi& E) {
    const int tid = threadIdx.x, wid = __builtin_amdgcn_readfirstlane(tid >> 6), lane = tid & 63, wr = wid >> 2, wc = wid & 3, fr = lane & 15, fq = lane >> 4;
    const int K = g.ld;
    unsigned voffA[2], voffB[2];
#pragma unroll
    for (int i = 0; i < 2; ++i) { int R, C; stage_rc(tid * 16 + i * 8192, R, C); const int Rb = Epi::PERM ? ((R & ~31) + perm32(R & 31)) : R;
        voffA[i] = (unsigned)(R * K + C) * 2u; voffB[i] = (unsigned)(Rb * K + C) * 2u; }
    const size_t kstep = (size_t)(BK * 2);
    const size_t hstep = (size_t)HALF * K * 2;
    const size_t tstep = 2 * hstep;
    const unsigned ldsw = (unsigned)wid * 1024u;
    const int aoff = lds_byte(wr * 64 + fr, fq * 8), boff = lds_byte(wc * 32 + fr, fq * 8);
#define PG8_SA(b, h) (((b) * 2 + (h)) * HTB)
#define PG8_SB(b, h) ((4 + (b) * 2 + (h)) * HTB)
#define PG8_STAGE(bufoff, gbase, voff) do { _Pragma("unroll") for (int _i = 0; _i < 2; ++_i) \
        __builtin_amdgcn_global_load_lds((const unsigned*)((const char*)(gbase) + (voff)[_i]), (PG8_LAS unsigned*)(lds + (bufoff) + ldsw + _i * 8192), 16, 0, 0); } while (0)
#define PG8_LDA(dst, b, h) do { _Pragma("unroll") for (int m = 0; m < 4; ++m) _Pragma("unroll") for (int k = 0; k < 2; ++k) dst[m][k] = *(const PG8_LAS bf16x8*)(lds + PG8_SA(b, h) + aoff + m * 2048 + k * 1024); } while (0)
#define PG8_LDB(dst, b, h) do { _Pragma("unroll") for (int n = 0; n < 2; ++n) _Pragma("unroll") for (int k = 0; k < 2; ++k) dst[n][k] = *(const PG8_LAS bf16x8*)(lds + PG8_SB(b, h) + boff + n * 2048 + k * 1024); } while (0)
#define PG8_MMA(ai, bj, At, Bt) do { __builtin_amdgcn_s_setprio(1); _Pragma("unroll") for (int m = 0; m < 4; ++m) _Pragma("unroll") for (int n = 0; n < 2; ++n) _Pragma("unroll") for (int k = 0; k < 2; ++k) \
        acc[ai][bj][m][n] = __builtin_amdgcn_mfma_f32_16x16x32_bf16(Bt[n][k], At[m][k], acc[ai][bj][m][n], 0, 0, 0); __builtin_amdgcn_s_setprio(0); } while (0)
#define PG8_WAIT_V(n) asm volatile("s_waitcnt vmcnt(" #n ")" ::: "memory")
#define PG8_WAIT_L(n) asm volatile("s_waitcnt lgkmcnt(" #n ")" ::: "memory")
#define PG8_BAR __builtin_amdgcn_s_barrier()
#define PG8_SCHED __builtin_amdgcn_sched_barrier(0)
    Unit cur, nxt; int ui = 0;
    if (!S.next(0, cur)) return;
    f32x4 acc[2][2][4][2];
#pragma unroll
    for (int a = 0; a < 2; ++a)
#pragma unroll
        for (int b = 0; b < 2; ++b)
#pragma unroll
            for (int m = 0; m < 4; ++m)
#pragma unroll
                for (int n = 0; n < 2; ++n) acc[a][b][m][n] = (f32x4){0.f, 0.f, 0.f, 0.f};
    bf16x8 At[4][2], B0[2][2], B1[2][2];
    const char* cA = (const char*)g.A + (size_t)cur.pm * tstep + (size_t)cur.k0 * 2; const char* cB = (const char*)g.Bt + (size_t)cur.pn * tstep + (size_t)cur.k0 * 2;
    S.a_ready(cur);
    if constexpr (SP2) {
        PG8_STAGE(PG8_SB(0, 0), cB, voffB); PG8_STAGE(PG8_SB(0, 1), cB + hstep, voffB); PG8_STAGE(PG8_SA(0, 0), cA, voffA); PG8_STAGE(PG8_SA(0, 1), cA + hstep, voffA);
        if (wr == 1) PG8_BAR;
        PG8_WAIT_V(2); PG8_BAR;
        PG8_STAGE(PG8_SB(1, 0), cB + kstep, voffB); PG8_STAGE(PG8_SA(1, 0), cA + kstep, voffA); PG8_STAGE(PG8_SB(1, 1), cB + hstep + kstep, voffB);
        PG8_WAIT_V(6); PG8_BAR;
    } else {
        PG8_STAGE(PG8_SB(0, 0), cB, voffB); PG8_STAGE(PG8_SA(0, 0), cA, voffA); PG8_STAGE(PG8_SB(0, 1), cB + hstep, voffB); PG8_STAGE(PG8_SA(0, 1), cA + hstep, voffA);
        if (wr == 1) PG8_BAR;
        PG8_WAIT_V(4); PG8_BAR;
        PG8_STAGE(PG8_SB(1, 0), cB + kstep, voffB); PG8_STAGE(PG8_SA(1, 0), cA + kstep, voffA); PG8_STAGE(PG8_SB(1, 1), cB + hstep + kstep, voffB);
        PG8_WAIT_V(6); PG8_BAR;
    }
    for (;;) {
        const bool has_next = S.next(ui + 1, nxt);
        const char* nA = has_next ? (const char*)g.A + (size_t)nxt.pm * tstep + (size_t)nxt.k0 * 2 : cA; const char* nB = has_next ? (const char*)g.Bt + (size_t)nxt.pn * tstep + (size_t)nxt.k0 * 2 : cB;
        const int nt = cur.nt;
        for (int t = 0; t < nt; t += 2) {
            const bool last = (t == nt - 2);
            const char* a1 = cA + (size_t)(t + 1) * kstep;
            const char* a2 = last ? nA : cA + (size_t)(t + 2) * kstep; const char* b2 = last ? nB : cB + (size_t)(t + 2) * kstep;
            const char* a3 = a2 + kstep; const char* b3 = b2 + kstep;
            if (last && has_next) S.a_ready(nxt);
            if constexpr (SP2) {
            PG8_LDB(B0, 0, 0); PG8_LDB(B1, 0, 1); PG8_SCHED; PG8_LDA(At, 0, 0); PG8_STAGE(PG8_SA(1, 1), a1 + hstep, voffA);
            PG8_WAIT_V(8); PG8_WAIT_L(0); PG8_BAR; PG8_MMA(0, 0, At, B0); PG8_MMA(0, 1, At, B1); PG8_BAR; PG8_SCHED;
            PG8_LDA(At, 0, 1); PG8_STAGE(PG8_SB(0, 0), b2, voffB); PG8_STAGE(PG8_SB(0, 1), b2 + hstep, voffB); PG8_STAGE(PG8_SA(0, 0), a2, voffA);
            PG8_WAIT_V(8); PG8_WAIT_L(0); PG8_BAR; PG8_MMA(1, 0, At, B0); PG8_MMA(1, 1, At, B1); PG8_BAR; PG8_SCHED;
            PG8_LDB(B0, 1, 0); PG8_LDB(B1, 1, 1); PG8_SCHED; PG8_LDA(At, 1, 0); PG8_STAGE(PG8_SA(0, 1), a2 + hstep, voffA);
            PG8_WAIT_V(8); PG8_WAIT_L(0); PG8_BAR; PG8_MMA(0, 0, At, B0); PG8_MMA(0, 1, At, B1); PG8_BAR; PG8_SCHED;
            PG8_LDA(At, 1, 1); PG8_STAGE(PG8_SB(1, 0), b3, voffB); PG8_STAGE(PG8_SB(1, 1), b3 + hstep, voffB); PG8_STAGE(PG8_SA(1, 0), a3, voffA);
            PG8_WAIT_V(8); PG8_WAIT_L(0); PG8_BAR; PG8_MMA(1, 0, At, B0); PG8_MMA(1, 1, At, B1); PG8_BAR; PG8_SCHED;
            } else {
            PG8_LDB(B0, 0, 0); PG8_SCHED; PG8_LDA(At, 0, 0); PG8_STAGE(PG8_SA(1, 1), a1 + hstep, voffA);
            PG8_WAIT_L(8); PG8_BAR; PG8_WAIT_L(0); PG8_MMA(0, 0, At, B0); PG8_BAR; PG8_SCHED;
            PG8_LDB(B1, 0, 1); PG8_STAGE(PG8_SB(0, 0), b2, voffB);
            PG8_BAR; PG8_WAIT_L(0); PG8_MMA(0, 1, At, B1); PG8_BAR;
            PG8_LDA(At, 0, 1); PG8_STAGE(PG8_SA(0, 0), a2, voffA);
            PG8_BAR; PG8_WAIT_L(0); PG8_MMA(1, 0, At, B0); PG8_BAR; PG8_SCHED;
            PG8_STAGE(PG8_SB(0, 1), b2 + hstep, voffB);
            PG8_WAIT_V(6); PG8_BAR; PG8_MMA(1, 1, At, B1); PG8_BAR;
            PG8_LDB(B0, 1, 0); PG8_SCHED; PG8_LDA(At, 1, 0); PG8_STAGE(PG8_SA(0, 1), a2 + hstep, voffA);
            PG8_WAIT_L(8); PG8_BAR; PG8_WAIT_L(0); PG8_MMA(0, 0, At, B0); PG8_BAR; PG8_SCHED;
            PG8_LDB(B1, 1, 1); PG8_STAGE(PG8_SB(1, 0), b3, voffB);
            PG8_BAR; PG8_WAIT_L(0); PG8_MMA(0, 1, At, B1); PG8_BAR;
            PG8_LDA(At, 1, 1); PG8_STAGE(PG8_SA(1, 0), a3, voffA);
            PG8_BAR; PG8_WAIT_L(0); PG8_MMA(1, 0, At, B0); PG8_BAR; PG8_SCHED;
            PG8_STAGE(PG8_SB(1, 1), b3 + hstep, voffB);
            PG8_WAIT_V(6); PG8_BAR; PG8_MMA(1, 1, At, B1); PG8_BAR;
            }
        }
        if constexpr (ALIGN_EPI) { if (wr == 0) PG8_BAR; }
        if constexpr (!Epi::AFTER_DRAIN) { E(acc, cur, wr, wc, fr, fq); S.done(cur); }
        if (!has_next) break;
#pragma unroll
        for (int a = 0; a < 2; ++a)
#pragma unroll
            for (int b = 0; b < 2; ++b)
#pragma unroll
                for (int m = 0; m < 4; ++m)
#pragma unroll
                    for (int n = 0; n < 2; ++n) acc[a][b][m][n] = (f32x4){0.f, 0.f, 0.f, 0.f};
        cur = nxt; cA = nA; cB = nB; ++ui;
        if constexpr (ALIGN_EPI) { if (wr == 1) PG8_BAR; }
    }
    PG8_WAIT_V(0);
    if constexpr (!ALIGN_EPI) { if (wr == 0) PG8_BAR; }
    PG8_BAR;
    if constexpr (Epi::AFTER_DRAIN) { E.fused(acc, cur, wr, wc, fr, fq, lds, wid, lane); S.done(cur); }
#undef PG8_SA
#undef PG8_SB
#undef PG8_STAGE
#undef PG8_LDA
#undef PG8_LDB
#undef PG8_MMA
#undef PG8_WAIT_V
#undef PG8_WAIT_L
#undef PG8_BAR
#undef PG8_SCHED
}
}

constexpr int DM = 2048, NCTX = 4096, NLAT = 8192, MTOK = NCTX + NLAT, DRG = 1024, DIN = 4096, DFF = 8192, NMOD6 = 12288, NCOND = 5;
constexpr int NCHUNK64 = MTOK / 64;
constexpr float EPSN = 1e-6f;
constexpr size_t MiB = 1u << 20;
constexpr size_t WS_MOD = 1 * MiB;
constexpr size_t WS_GWT = 2 * MiB;
constexpr size_t WS_SUMM = 4 * MiB;
constexpr int LD2 = DM + 64, LD8 = DFF + 64;
constexpr size_t WS_WFF2 = 8 * MiB;
constexpr size_t WS_WIN = 41 * MiB;
constexpr size_t WS_WOUT = 58 * MiB;
constexpr size_t WS_WFF1 = 67 * MiB;
constexpr size_t WS_H = 100 * MiB;
constexpr size_t WS_PROJ = 150 * MiB;
constexpr size_t WS_MIX = 246 * MiB;
constexpr size_t WS_F = 150 * MiB;
constexpr size_t WS_PART = 344 * MiB;
constexpr size_t WS_D1 = WS_PROJ;
constexpr size_t WS_AB0 = WS_H;
constexpr size_t WS_AB1 = 296 * MiB;
constexpr size_t WS_D2 = WS_H;
constexpr size_t WS_X1A = 41 * MiB;
constexpr size_t WS_X1B = 360 * MiB;
constexpr size_t WS_END = 384 * MiB;
static_assert(WS_WFF2 + (size_t)DM * LD8 * 2 <= WS_WIN && WS_WIN + (size_t)DIN * LD2 * 2 <= WS_WOUT && WS_WOUT + (size_t)DM * LD2 * 2 <= WS_WFF1 && WS_WFF1 + (size_t)DFF * LD2 * 2 <= WS_H &&
              WS_H + (size_t)MTOK * LD2 * 2 <= WS_PROJ && WS_PROJ + (size_t)MTOK * DIN * 2 <= WS_MIX && WS_MIX + (size_t)MTOK * LD2 * 2 <= WS_PART && WS_F + (size_t)MTOK * LD8 * 2 <= WS_PART &&
              WS_MIX + (size_t)MTOK * LD2 * 2 <= WS_AB1 && WS_AB1 + (size_t)NCHUNK64 * 8 * 4 * 8 * 64 * 16 <= WS_PART && (size_t)NCHUNK64 * 8 * 4 * 8 * 64 * 16 <= (size_t)MTOK * LD2 * 2, "d_ws map");
static_assert(WS_X1A + (size_t)6144 * DM * 2 <= WS_WFF1 && WS_PART + (size_t)4096 * DM * 2 <= WS_X1B && WS_X1B + (size_t)6144 * DM * 2 <= WS_END, "x1 halves");
constexpr int LDS_BYTES = 147456;
constexpr int NWAVES = 8, NTHR = 512;

#define GAS __attribute__((address_space(1)))
#define LAS __attribute__((address_space(3)))
typedef unsigned short bf16;
typedef unsigned v4u __attribute__((ext_vector_type(4)));
typedef unsigned v2u __attribute__((ext_vector_type(2)));
typedef float f32x4 __attribute__((ext_vector_type(4)));
typedef float f32x2 __attribute__((ext_vector_type(2)));
typedef short bf16x8 __attribute__((ext_vector_type(8)));
#define LDS_WAIT() asm volatile("s_waitcnt lgkmcnt(0)" ::: "memory")
__device__ __forceinline__ unsigned pk2(float lo, float hi) { return pg8::cvt_pk_bf16(lo, hi); }
__device__ __forceinline__ float bflo(unsigned u) { return __builtin_bit_cast(float, u << 16); }
__device__ __forceinline__ float bfhi(unsigned u) { return __builtin_bit_cast(float, u & 0xffff0000u); }
__device__ __forceinline__ float wave_sum(float v) {
#pragma unroll
    for (int o = 1; o < 64; o <<= 1) v += __shfl_xor(v, o);
    return v;
}
__device__ __forceinline__ float sigmoidf_(float x) { return __builtin_amdgcn_rcpf(1.0f + __builtin_amdgcn_exp2f(-1.442695041f * x)); }

struct Params {
    const float* in[23];
    float* out; unsigned char* ws;
    int ph_lo, ph_hi;
};

template <bool NT  >
__device__ __forceinline__ void p0_transpose_item(const float* W, int K, int N, bf16* WT, int ldt, LAS float* scr, int item, int lane) {
    const int nblk = N / 32, kb = item / nblk, nb = item % nblk, k0 = 64 * kb, n0 = 32 * nb;
    f32x4 wv[8];
#pragma unroll
    for (int i = 0; i < 8; ++i) wv[i] = __builtin_nontemporal_load((const f32x4*)(W + (size_t)(k0 + 8 * i + (lane >> 3)) * N + n0 + 4 * (lane & 7)));
#pragma unroll
    for (int i = 0; i < 8; ++i) { LAS float* d = scr + (8 * i + (lane >> 3)) * 33 + 4 * (lane & 7); d[0] = wv[i].x; d[1] = wv[i].y; d[2] = wv[i].z; d[3] = wv[i].w; }
    LDS_WAIT(); asm volatile("" ::: "memory");
    const int c = lane & 7;
#pragma unroll
    for (int j = 0; j < 4; ++j) { const int n = (lane >> 3) + 8 * j; const LAS float* s = scr + (8 * c) * 33 + n;
        v4u o; o.x = pk2(s[0 * 33], s[1 * 33]); o.y = pk2(s[2 * 33], s[3 * 33]); o.z = pk2(s[4 * 33], s[5 * 33]); o.w = pk2(s[6 * 33], s[7 * 33]);
        if (NT) __builtin_nontemporal_store(o, (v4u*)(WT + (size_t)(n0 + n) * ldt + k0 + 8 * c)); else *(v4u*)(WT + (size_t)(n0 + n) * ldt + k0 + 8 * c) = o; }
    LDS_WAIT(); asm volatile("" ::: "memory");
}
__device__ __forceinline__ void tr_load(const float* Wt  , int N, int lane, f32x4 (&wv)[8]) {
#pragma unroll
    for (int i = 0; i < 8; ++i) wv[i] = __builtin_nontemporal_load((const f32x4*)(Wt + (size_t)(8 * i + (lane >> 3)) * N + 4 * (lane & 7)));
}
__device__ __forceinline__ void tr_store(bf16* WTt  , int ldt, int lane, const f32x4 (&wv)[8], LAS float* scr) {
#pragma unroll
    for (int i = 0; i < 8; ++i) { LAS float* d = scr + (8 * i + (lane >> 3)) * 33 + 4 * (lane & 7); d[0] = wv[i].x; d[1] = wv[i].y; d[2] = wv[i].z; d[3] = wv[i].w; }
    LDS_WAIT(); asm volatile("" ::: "memory");
    const int c = lane & 7;
#pragma unroll
    for (int j = 0; j < 4; ++j) { const int n = (lane >> 3) + 8 * j; const LAS float* s = scr + (8 * c) * 33 + n;
        v4u o; o.x = pk2(s[0 * 33], s[1 * 33]); o.y = pk2(s[2 * 33], s[3 * 33]); o.z = pk2(s[4 * 33], s[5 * 33]); o.w = pk2(s[6 * 33], s[7 * 33]);
        __builtin_nontemporal_store(o, (v4u*)(WTt + (size_t)n * ldt + 8 * c)); }
    LDS_WAIT(); asm volatile("" ::: "memory");
}
constexpr int I_FF2 = (DFF / 64) * (DM / 32), I_FF1 = (DM / 64) * (DFF / 32), I_IN = (DM / 64) * (DIN / 32), I_OUT = (DM / 64) * (DM / 32), I_G = 32 * 8;
constexpr int I_TOTAL = I_FF2 + I_FF1 + I_IN + I_OUT + I_G;
constexpr int I_DEFER = 12288, I_FF2_DEF = 4096;
constexpr int I_P0 = I_TOTAL - I_DEFER;
static_assert(I_FF1 + I_FF2_DEF == I_DEFER && I_DEFER == 256 * 6 * 8 && I_P0 == 256 * 41, "deferred weight-copy split");
constexpr int GEMV_CNT_WORD = 3600;

__device__ __forceinline__ void phase0(const Params& P, LAS unsigned char* lds) {
    const int tid = threadIdx.x, lane = tid & 63, wave = __builtin_amdgcn_readfirstlane(tid >> 6);
    const int G = gridDim.x, bx = blockIdx.x;
    unsigned char* ws = P.ws;
    {
        LAS float* s = (LAS float*)(lds + 67584);
        LAS float* red = (LAS float*)(lds + 108544);
        for (int i = tid; i < NCOND * DM; i += NTHR) { const int j = i >> 11, k = i & 2047; const float cv = (j == 0) ? P.in[4][k] : P.in[2][(j - 1) * DM + k];
            s[i] = cv * sigmoidf_(cv); }
        __syncthreads();
        for (int cb = bx; cb < 256; cb += G) {
            const int c4 = lane & 15, sub = lane >> 4, n0 = cb * 48; const bool act = c4 < 12;
            f32x4 acc[NCOND];
#pragma unroll
            for (int j = 0; j < NCOND; ++j) acc[j] = (f32x4){0.f, 0.f, 0.f, 0.f};
            const float* wp = P.in[6] + (size_t)(wave * 4 + sub) * NMOD6 + n0 + (act ? c4 : 0) * 4;
#pragma unroll 8
            for (int i = 0; i < 64; ++i) { const int r = i * 32 + wave * 4 + sub; const f32x4 wv = __builtin_nontemporal_load((const f32x4*)(wp + (size_t)i * 32 * NMOD6));
#pragma unroll
                for (int j = 0; j < NCOND; ++j) acc[j] += s[j * DM + r] * wv; }
#pragma unroll
            for (int j = 0; j < NCOND; ++j)
#pragma unroll
                for (int e = 0; e < 4; ++e) { float v = acc[j][e]; v += __shfl_xor(v, 16); v += __shfl_xor(v, 32); if (sub == 0 && act) red[(wave * NCOND + j) * 48 + c4 * 4 + e] = v; }
            __syncthreads();
            if (tid < NCOND * 48) { const int j = tid / 48, cc = tid - j * 48; float v = P.in[7][n0 + cc];
#pragma unroll
                for (int w = 0; w < 8; ++w) v += red[(w * NCOND + j) * 48 + cc];
                ((float*)(ws + WS_MOD))[j * NMOD6 + n0 + cc] = v; }
            __syncthreads();
        }
        asm volatile("s_waitcnt vmcnt(0)" ::: "memory"); __syncthreads();
        if (tid == 0) { __builtin_amdgcn_fence(__ATOMIC_RELEASE, "agent"); asm volatile("s_waitcnt vmcnt(0)" ::: "memory");
            __hip_atomic_fetch_add((unsigned*)ws + GEMV_CNT_WORD, 1u, __ATOMIC_RELAXED, __HIP_MEMORY_SCOPE_AGENT); }
    }
    LAS float* scr = (LAS float*)(lds + wave * 8448);
    const int per = (I_P0 + G - 1) / G, start = bx * per;
    for (int q = wave; q < per; q += NWAVES) {
        int r = start + q; if (r >= I_P0) break;
        if (r < I_FF2 - I_FF2_DEF) { p0_transpose_item<true>(P.in[21], DFF, DM, (bf16*)(ws + WS_WFF2), LD8, scr, r + I_FF2_DEF, lane); continue; } r -= I_FF2 - I_FF2_DEF;
        if (r < I_IN) { p0_transpose_item<false>(P.in[8], DM, DIN, (bf16*)(ws + WS_WIN), LD2, scr, r, lane); continue; } r -= I_IN;
        if (r < I_OUT) { p0_transpose_item<true>(P.in[18], DM, DM, (bf16*)(ws + WS_WOUT), LD2, scr, r, lane); continue; } r -= I_OUT;
        { const int mat = r >> 3, it = r & 7, type = mat & 1, dh = mat >> 1;
          p0_transpose_item<false>((type ? P.in[13] : P.in[11]) + (size_t)dh * 16384, 128, 128, (bf16*)(ws + WS_GWT) + (size_t)mat * 16384, 128, scr, it, lane); }
    }
}
#define TR_DEFERRED(it, b, w, Wt, WTt, Nn, Ld) do { const bool _f1 = (it) < 4; const float* _W = _f1 ? P.in[20] : P.in[21]; bf16* _WT = (bf16*)(P.ws + (_f1 ? WS_WFF1 : WS_WFF2)); \
        Nn = _f1 ? DFF : DM; Ld = _f1 ? LD2 : LD8; const int _item = (((it) - (_f1 ? 0 : 4)) * 256 + (b)) * 8 + (w); \
        const int _nblk = Nn / 32, _k0 = 64 * (_item / _nblk), _n0 = 32 * (_item % _nblk); \
        Wt = _W + (size_t)_k0 * Nn + _n0; WTt = _WT + (size_t)_n0 * Ld + _k0; } while (0)
__device__ __forceinline__ void gemv_wait(const Params& P) {
    if (threadIdx.x == 0) { unsigned* w = (unsigned*)P.ws + GEMV_CNT_WORD; unsigned sp = 0;
        while (__hip_atomic_load(w, __ATOMIC_RELAXED, __HIP_MEMORY_SCOPE_AGENT) < gridDim.x) { __builtin_amdgcn_s_sleep(2); if (++sp > (1u << 22)) break; }
        __builtin_amdgcn_fence(__ATOMIC_ACQUIRE, "agent"); asm volatile("s_waitcnt vmcnt(0)" ::: "memory"); }
    __syncthreads();
}

constexpr int HEAD_CNT_WORD = 3616;
__device__ __forceinline__ void head_publish(const Params& P) {
    asm volatile("s_waitcnt vmcnt(0)" ::: "memory"); __syncthreads();
    if (threadIdx.x == 0) { __builtin_amdgcn_fence(__ATOMIC_RELEASE, "agent"); asm volatile("s_waitcnt vmcnt(0)" ::: "memory");
        __hip_atomic_fetch_add((unsigned*)P.ws + HEAD_CNT_WORD + 8 * (blockIdx.x & 7), 1u, __ATOMIC_RELAXED, __HIP_MEMORY_SCOPE_AGENT); }
}
__device__ __forceinline__ void head_wait(const Params& P) {
    asm volatile("s_waitcnt vmcnt(0)" ::: "memory"); __syncthreads();
    if (threadIdx.x == 0) { unsigned* w = (unsigned*)P.ws + HEAD_CNT_WORD + 8 * (blockIdx.x & 7); unsigned sp = 0;
        while (__hip_atomic_load(w, __ATOMIC_RELAXED, __HIP_MEMORY_SCOPE_AGENT) < (gridDim.x >> 3)) { __builtin_amdgcn_s_sleep(2); if (++sp > (1u << 22)) break; }
        __builtin_amdgcn_fence(__ATOMIC_ACQUIRE, "agent"); asm volatile("s_waitcnt vmcnt(0)" ::: "memory"); }
    __syncthreads();
}

template <int WHICH  >
__device__ __forceinline__ void norm_mod_phase(const Params& P) {
    const int tid = threadIdx.x, lane = tid & 63, wave = __builtin_amdgcn_readfirstlane(tid >> 6);
    const int gw = blockIdx.x * NWAVES + wave, NGW = gridDim.x * NWAVES;
    const int per = (MTOK + NGW - 1) / NGW;
    const float* mod = (const float*)(P.ws + WS_MOD);
    const float* g = WHICH == 1 ? P.in[5] : P.in[19];
    const int sh_off = WHICH == 1 ? 0 : 3 * DM, sc_off = sh_off + DM;
    bf16* H = (bf16*)(P.ws + WS_H);
    int cur = -1; f32x4 cm[8], sh[8], vn[8];
    const int r0 = gw * per, r1 = ((gw + 1) * per < MTOK) ? (gw + 1) * per : MTOK;
#define NM_XROW(r) ((r) < NCTX ? P.in[0] + (size_t)(r) * DM : P.in[1] + (size_t)((r) - NCTX) * DM)
    if (r0 < r1) { const float* xr = NM_XROW(r0);
#pragma unroll
        for (int j = 0; j < 8; ++j) vn[j] = __builtin_nontemporal_load((const f32x4*)xr + lane + 64 * j); }
    for (int row = r0; row < r1; ++row) {
        const int cond = row < NCTX ? 0 : 1 + ((row - NCTX) >> 11);
        if (cond != cur) { cur = cond;
#pragma unroll
            for (int j = 0; j < 8; ++j) { const f32x4 g4 = ((const f32x4*)g)[lane + 64 * j], s4 = ((const f32x4*)(mod + cond * NMOD6 + sc_off))[lane + 64 * j];
                cm[j] = g4 * (s4 + 1.0f); sh[j] = ((const f32x4*)(mod + cond * NMOD6 + sh_off))[lane + 64 * j]; } }
        f32x4 v[8]; float ss = 0.f;
#pragma unroll
        for (int j = 0; j < 8; ++j) v[j] = vn[j];
        if (row + 1 < r1) { const float* xr = NM_XROW(row + 1);
#pragma unroll
            for (int j = 0; j < 8; ++j) vn[j] = __builtin_nontemporal_load((const f32x4*)xr + lane + 64 * j); }
        if (WHICH == 2) {
            const v2u* dr = (const v2u*)((const bf16*)(P.ws + WS_D1) + (size_t)row * DM) + lane;
#pragma unroll
            for (int j = 0; j < 8; ++j) { const v2u d = __builtin_nontemporal_load(dr + 64 * j); v[j] += (f32x4){bflo(d.x), bfhi(d.x), bflo(d.y), bfhi(d.y)}; }
            if (row >= 8192) { const v2u* pr = (const v2u*)((const bf16*)(P.ws + WS_PART) + (size_t)(row - 8192) * DM) + lane;
#pragma unroll
                for (int j = 0; j < 8; ++j) { const v2u d = __builtin_nontemporal_load(pr + 64 * j); v[j] += (f32x4){bflo(d.x), bfhi(d.x), bflo(d.y), bfhi(d.y)}; } }
            v2u* xw = (v2u*)((bf16*)(P.ws + (row < 6144 ? WS_X1A : WS_X1B)) + (size_t)(row < 6144 ? row : row - 6144) * DM) + lane;
#pragma unroll
            for (int j = 0; j < 8; ++j) { v2u w; w.x = pk2(v[j].x, v[j].y); w.y = pk2(v[j].z, v[j].w); __builtin_nontemporal_store(w, xw + 64 * j); } }
#pragma unroll
        for (int j = 0; j < 8; ++j) ss += (v[j].x * v[j].x + v[j].y * v[j].y) + (v[j].z * v[j].z + v[j].w * v[j].w);
        const float rinv = 1.0f / sqrtf(wave_sum(ss) * (1.0f / DM) + EPSN);
        v2u* o8 = (v2u*)(H + (size_t)row * LD2) + lane;
#pragma unroll
        for (int j = 0; j < 8; ++j) { const f32x4 y = v[j] * rinv * cm[j] + sh[j]; v2u w; w.x = pk2(y.x, y.y); w.y = pk2(y.z, y.w); o8[64 * j] = w; }
    }
}
__device__ __forceinline__ void final_norm_phase(const Params& P, float* dst) {
    const int tid = threadIdx.x, lane = tid & 63, wave = __builtin_amdgcn_readfirstlane(tid >> 6);
    const int gw = blockIdx.x * NWAVES + wave, NGW = gridDim.x * NWAVES;
    f32x4 g4[8];
#pragma unroll
    for (int j = 0; j < 8; ++j) g4[j] = ((const f32x4*)P.in[22])[lane + 64 * j];
    v2u vn[8];
#define FN_X1ROW(r) ((const v2u*)((const bf16*)(P.ws + ((r) < 6144 ? WS_X1A : WS_X1B)) + (size_t)((r) < 6144 ? (r) : (r) - 6144) * DM) + lane)
    if (gw < MTOK) { const v2u* xr0 = FN_X1ROW(gw);
#pragma unroll
        for (int j = 0; j < 8; ++j) vn[j] = __builtin_nontemporal_load(xr0 + 64 * j); }
    for (int row = gw; row < MTOK; row += NGW) {
        f32x4 v[8]; float ss = 0.f;
#pragma unroll
        for (int j = 0; j < 8; ++j) v[j] = (f32x4){bflo(vn[j].x), bfhi(vn[j].x), bflo(vn[j].y), bfhi(vn[j].y)};
        if (row + NGW < MTOK) { const v2u* xr1 = FN_X1ROW(row + NGW);
#pragma unroll
            for (int j = 0; j < 8; ++j) vn[j] = __builtin_nontemporal_load(xr1 + 64 * j); }
        { const v2u* dr = (const v2u*)((const bf16*)(P.ws + WS_D2) + (size_t)row * DM) + lane;
#pragma unroll
            for (int j = 0; j < 8; ++j) { const v2u d = __builtin_nontemporal_load(dr + 64 * j); v[j] += (f32x4){bflo(d.x), bfhi(d.x), bflo(d.y), bfhi(d.y)}; } }
        if (row >= 8192) { const v2u* pr = (const v2u*)((const bf16*)(P.ws + WS_PART) + (size_t)(row - 8192) * DM) + lane;
#pragma unroll
            for (int j = 0; j < 8; ++j) { const v2u d = __builtin_nontemporal_load(pr + 64 * j); v[j] += (f32x4){bflo(d.x), bfhi(d.x), bflo(d.y), bfhi(d.y)}; } }
#pragma unroll
        for (int j = 0; j < 8; ++j) ss += (v[j].x * v[j].x + v[j].y * v[j].y) + (v[j].z * v[j].z + v[j].w * v[j].w);
        const float rinv = 1.0f / sqrtf(wave_sum(ss) * (1.0f / DM) + EPSN);
        f32x4* xo = (f32x4*)(dst + (size_t)row * DM) + lane;
#pragma unroll
        for (int j = 0; j < 8; ++j) __builtin_nontemporal_store(v[j] * rinv * g4[j], xo + 64 * j);
    }
}

constexpr int XCA_P = 136;
constexpr int XCF_P = 132;
constexpr int L_XCA = 0, L_XCF = 17408, L_CW = 51200, L_HT = 53760;
static_assert(L_XCF == 64 * XCA_P * 2 && L_CW == L_XCF + 64 * XCF_P * 4 && L_HT == L_CW + 5 * 128 * 4 && L_HT + 2 * 64 * XCF_P * 4 <= 131072 && 32 * 256 * 8 <= 2 * 64 * XCF_P * 4, "rg LDS map");

template <bool REV>
__device__ __forceinline__ void scan_chunk(const LAS bf16* XCA, const LAS float* XCF, v4u* ABw, const bf16x8 (&Br)[2][4], const bf16x8 (&Bi)[2][4],
                                           const float (&bA)[2], const float (&bI)[2], const float (&sp)[2], float (&cout)[2], float (&pout)[2], int fr, int fq, int q) {
    float carry[2] = {0.f, 0.f}, ptot[2] = {1.0f, 1.0f};
#pragma unroll
    for (int mm = 0; mm < 4; ++mm) { const int m = REV ? 3 - mm : mm;
        f32x4 ar[2], ai[2];
#pragma unroll
        for (int n = 0; n < 2; ++n) { ar[n] = (f32x4){0.f, 0.f, 0.f, 0.f}; ai[n] = (f32x4){0.f, 0.f, 0.f, 0.f}; }
#pragma unroll
        for (int ks = 0; ks < 4; ++ks) { const bf16x8 a = *(const LAS bf16x8*)(XCA + (m * 16 + fr) * XCA_P + ks * 32 + fq * 8);
#pragma unroll
            for (int n = 0; n < 2; ++n) { ar[n] = __builtin_amdgcn_mfma_f32_16x16x32_bf16(a, Br[n][ks], ar[n], 0, 0, 0); ai[n] = __builtin_amdgcn_mfma_f32_16x16x32_bf16(a, Bi[n][ks], ai[n], 0, 0, 0); } }
#pragma unroll
        for (int n = 0; n < 2; ++n) {
            float la[4], bb[4];
            v4u w;
#pragma unroll
            for (int h = 0; h < 2; ++h) {
                const f32x2 kk = (f32x2){-1.442695041f, -1.442695041f}, one = (f32x2){1.0f, 1.0f};
                const f32x2 rp = (f32x2){ar[n][2 * h], ar[n][2 * h + 1]}, ip = (f32x2){ai[n][2 * h], ai[n][2 * h + 1]};
                const f32x2 tr = rp * kk + (f32x2){bA[n], bA[n]}, ti = ip * kk + (f32x2){bI[n], bI[n]};
                f32x2 er, ei; er.x = __builtin_amdgcn_exp2f(tr.x); er.y = __builtin_amdgcn_exp2f(tr.y); ei.x = __builtin_amdgcn_exp2f(ti.x); ei.y = __builtin_amdgcn_exp2f(ti.y);
                const f32x2 dr = er + one, v = ei + one;
                f32x2 rc; rc.x = __builtin_amdgcn_rcpf(dr.x); rc.y = __builtin_amdgcn_rcpf(dr.y);
                const f32x2 l2 = rc * (f32x2){sp[n], sp[n]};
                const unsigned wl = pk2(l2.x, l2.y);
                f32x2 a; a.x = __builtin_amdgcn_exp2f(bflo(wl)); a.y = __builtin_amdgcn_exp2f(bfhi(wl));
                f32x2 u = one - a * a; u.x = fmaxf(u.x, 1e-30f); u.y = fmaxf(u.y, 1e-30f);
                const f32x2 uv = u * v * v;
                f32x2 rs; rs.x = __builtin_amdgcn_rsqf(uv.x); rs.y = __builtin_amdgcn_rsqf(uv.y);
                const f32x2 xc = (f32x2){XCF[(m * 16 + fq * 4 + 2 * h) * XCF_P + q * 32 + n * 16 + fr], XCF[(m * 16 + fq * 4 + 2 * h + 1) * XCF_P + q * 32 + n * 16 + fr]};
                const f32x2 b = u * rs * xc;
                const unsigned wb = pk2(b.x, b.y);
                la[2 * h] = a.x; la[2 * h + 1] = a.y; bb[2 * h] = bflo(wb); bb[2 * h + 1] = bfhi(wb);
                if (h == 0) { w.x = wl; w.z = wb; } else { w.y = wl; w.w = wb; }
            }
            __builtin_nontemporal_store(w, ABw + (m * 2 + n) * 64);
            float Pl = 1.0f, Hl = 0.0f;
#pragma unroll
            for (int jj = 0; jj < 4; ++jj) { const int j = REV ? 3 - jj : jj; Hl = la[j] * Hl + bb[j]; Pl *= la[j]; }
#pragma unroll
            for (int kk = 0; kk < 4; ++kk) { const int k = REV ? 3 - kk : kk;
                const float Pk = __shfl(Pl, fr + 16 * k), Hk = __shfl(Hl, fr + 16 * k);
                carry[n] = Pk * carry[n] + Hk; ptot[n] *= Pk; }
        }
    }
    cout[0] = carry[0]; cout[1] = carry[1]; pout[0] = ptot[0]; pout[1] = ptot[1];
}
template <bool REV>
__device__ __forceinline__ void scan_final(const v4u (&ab)[8], LAS float* HTd, const float (&cin)[2], float (&cout)[2], int fr, int fq, int q) {
    float carry[2] = {cin[0], cin[1]};
#pragma unroll
    for (int mm = 0; mm < 4; ++mm) { const int m = REV ? 3 - mm : mm;
#pragma unroll
        for (int n = 0; n < 2; ++n) { const v4u w = ab[m * 2 + n];
            float la[4] = {bflo(w.x), bfhi(w.x), bflo(w.y), bfhi(w.y)}; const float bb[4] = {bflo(w.z), bfhi(w.z), bflo(w.w), bfhi(w.w)};
#pragma unroll
            for (int j = 0; j < 4; ++j) la[j] = __builtin_amdgcn_exp2f(la[j]);
            float Pl = 1.0f, Hl = 0.0f;
#pragma unroll
            for (int jj = 0; jj < 4; ++jj) { const int j = REV ? 3 - jj : jj; Hl = la[j] * Hl + bb[j]; Pl *= la[j]; }
            float my = 0.0f;
#pragma unroll
            for (int kk = 0; kk < 4; ++kk) { const int k = REV ? 3 - kk : kk;
                const float Pk = __shfl(Pl, fr + 16 * k), Hk = __shfl(Hl, fr + 16 * k);
                if (k == fq) my = carry[n];
                carry[n] = Pk * carry[n] + Hk; }
            float h = my;
#pragma unroll
            for (int jj = 0; jj < 4; ++jj) { const int j = REV ? 3 - jj : jj; h = la[j] * h + bb[j]; HTd[(m * 16 + fq * 4 + j) * XCF_P + q * 32 + n * 16 + fr] = h; }
        }
    }
    cout[0] = carry[0]; cout[1] = carry[1];
}

__device__ __forceinline__ void rg_phase1(const Params& P, LAS unsigned char* lds) {
    const int tid = threadIdx.x, lane = tid & 63, wave = __builtin_amdgcn_readfirstlane(tid >> 6), fr = lane & 15, fq = lane >> 4;
    const int head = blockIdx.x & 7, jb = blockIdx.x >> 3, nb = gridDim.x >> 3;
    const int dir = wave >> 2, q = wave & 3;
    unsigned char* ws = P.ws;
    const bf16* proj = (const bf16*)(ws + WS_PROJ);
    f32x2* summ = (f32x2*)(ws + WS_SUMM);
    v4u* AB = (v4u*)(ws + (dir == 0 ? WS_AB0 : WS_AB1));
    LAS bf16* XCA = (LAS bf16*)(lds + L_XCA);
    LAS float* XCF = (LAS float*)(lds + L_XCF);
    LAS float* CW = (LAS float*)(lds + L_CW);
    const bf16* gwr = (const bf16*)(ws + WS_GWT) + (size_t)((dir * 8 + head) * 2) * 16384, * gwi = gwr + 16384;
    bf16x8 Br[2][4], Bi[2][4];
#pragma unroll
    for (int n = 0; n < 2; ++n)
#pragma unroll
        for (int ks = 0; ks < 4; ++ks) { const int off = (q * 32 + n * 16 + fr) * 128 + ks * 32 + fq * 8; Br[n][ks] = *(const bf16x8*)(gwr + off); Bi[n][ks] = *(const bf16x8*)(gwi + off); }
    float bA[2], bI[2], sp[2];
#pragma unroll
    for (int n = 0; n < 2; ++n) { const int ch = dir * DRG + head * 128 + q * 32 + n * 16 + fr; bA[n] = -1.442695041f * P.in[12][ch]; bI[n] = -1.442695041f * P.in[14][ch]; sp[n] = -1.442695041f * 8.0f * log1pf(__expf(-P.in[15][ch])); }
    for (int i = tid; i < 5 * 128; i += NTHR) { const int k = i >> 7, c = i & 127; CW[i] = k < 4 ? P.in[9][k * DRG + head * 128 + c] : P.in[10][head * 128 + c]; }
    __syncthreads();
    v4u xr[4][2];
#define RG_LOAD_ITEM(cc) do { const int _row0 = (cc) * 64; int _s0, _s1; if (_row0 < NCTX) { _s0 = _row0 & ~255; _s1 = _s0 + 256; } else { _s0 = NCTX + ((_row0 - NCTX) & ~2047); _s1 = _s0 + 2048; } \
        const int _tl = tid >> 3, _c0 = (tid & 7) * 16; \
        _Pragma("unroll") for (int k = 0; k < 4; ++k) { const int r = _row0 + _tl + k - 2; xr[k][0] = (v4u){0u, 0u, 0u, 0u}; xr[k][1] = (v4u){0u, 0u, 0u, 0u}; \
            if (r >= _s0 && r < _s1) { const v4u* src = (const v4u*)(proj + (size_t)r * DIN + DRG + head * 128 + _c0); xr[k][0] = src[0]; xr[k][1] = src[1]; } } \
        } while (0)
    for (int c = jb; c < NCHUNK64; c += nb) {
        RG_LOAD_ITEM(c);
        { const int tl = tid >> 3, c0 = (tid & 7) * 16;
          float xv[16];
#pragma unroll
          for (int e4 = 0; e4 < 4; ++e4) { const f32x4 b4 = *(const LAS f32x4*)(CW + 4 * 128 + c0 + 4 * e4); xv[4 * e4] = b4.x; xv[4 * e4 + 1] = b4.y; xv[4 * e4 + 2] = b4.z; xv[4 * e4 + 3] = b4.w; }
#pragma unroll
          for (int k = 0; k < 4; ++k) { const v4u x0 = xr[k][0], x1 = xr[k][1];
              const unsigned xw[8] = {x0.x, x0.y, x0.z, x0.w, x1.x, x1.y, x1.z, x1.w};
#pragma unroll
              for (int e2 = 0; e2 < 8; ++e2) { const f32x2 w2 = *(const LAS f32x2*)(CW + k * 128 + c0 + 2 * e2); xv[2 * e2] += w2.x * bflo(xw[e2]); xv[2 * e2 + 1] += w2.y * bfhi(xw[e2]); } }
#pragma unroll
          for (int e4 = 0; e4 < 4; ++e4) *(LAS f32x4*)(XCF + tl * XCF_P + c0 + 4 * e4) = (f32x4){xv[4 * e4], xv[4 * e4 + 1], xv[4 * e4 + 2], xv[4 * e4 + 3]};
          v4u a0, a1; a0.x = pk2(xv[0], xv[1]); a0.y = pk2(xv[2], xv[3]); a0.z = pk2(xv[4], xv[5]); a0.w = pk2(xv[6], xv[7]);
          a1.x = pk2(xv[8], xv[9]); a1.y = pk2(xv[10], xv[11]); a1.z = pk2(xv[12], xv[13]); a1.w = pk2(xv[14], xv[15]);
          *(LAS v4u*)(XCA + tl * XCA_P + c0) = a0; *(LAS v4u*)(XCA + tl * XCA_P + c0 + 8) = a1; }
        const int trit = (c - jb) / nb;
        f32x4 trv[8];
        const bool tr_on = (gridDim.x == 256);
        const float* trW; bf16* trWT; int trN, trLd;
        TR_DEFERRED(trit, (int)blockIdx.x, wave, trW, trWT, trN, trLd);
        if (tr_on) tr_load(trW, trN, lane, trv);
        __syncthreads();
        float cout[2], pout[2];
        v4u* ABw = AB + ((size_t)((c * 8 + head) * 4 + q) * 8) * 64 + lane;
        if (dir == 0) scan_chunk<false>(XCA, XCF, ABw, Br, Bi, bA, bI, sp, cout, pout, fr, fq, q);
        else scan_chunk<true>(XCA, XCF, ABw, Br, Bi, bA, bI, sp, cout, pout, fr, fq, q);
        if (fq == 0) {
#pragma unroll
            for (int n = 0; n < 2; ++n) summ[((size_t)(dir * NCHUNK64 + c) * 8 + head) * 128 + q * 32 + n * 16 + fr] = (f32x2){pout[n], cout[n]}; }
        if (tr_on) tr_store(trWT, trLd, lane, trv, (LAS float*)(lds + L_HT + wave * 8448));
        __syncthreads();
    }
    if (gridDim.x != 256) {
        LAS float* scr = (LAS float*)(lds + L_HT + wave * 8448);
        for (int d = blockIdx.x * NWAVES + wave; d < 256 * 6 * NWAVES; d += gridDim.x * NWAVES) { const int w_ = d & 7, it_ = (d >> 3) % 6, b_ = (d >> 3) / 6; const float* tw_; bf16* twt_; int tn_, tl_; TR_DEFERRED(it_, b_, w_, tw_, twt_, tn_, tl_); f32x4 wv[8]; tr_load(tw_, tn_, lane, wv); tr_store(twt_, tl_, lane, wv, scr); }
    }
#undef RG_LOAD_ITEM
}
__device__ __forceinline__ void rg_phase2(const Params& P, LAS unsigned char* lds) {
    const int tid = threadIdx.x, lane = tid & 63, wave = __builtin_amdgcn_readfirstlane(tid >> 6), fr = lane & 15, fq = lane >> 4;
    const int head = blockIdx.x & 7, jb = blockIdx.x >> 3, nb = gridDim.x >> 3;
    const int dir = wave >> 2, q = wave & 3;
    unsigned char* ws = P.ws;
    const bf16* proj = (const bf16*)(ws + WS_PROJ);
    bf16* mix = (bf16*)(ws + WS_MIX);
    const f32x2* summ = (const f32x2*)(ws + WS_SUMM);
    const v4u* AB = (const v4u*)(ws + (dir == 0 ? WS_AB0 : WS_AB1));
    LAS f32x2* CARRY = (LAS f32x2*)lds;
    LAS float* HT = (LAS float*)(lds + 63488);
    static_assert(31 * 256 * 8 == 63488 && 63488 + 2 * 64 * XCF_P * 4 <= 131072, "pass-2 LDS map");
    v4u abn[8]; f32x4 cpre[8];
#define RG_LOAD_AB(cc) do { const v4u* _s = AB + ((size_t)(((cc) * 8 + head) * 4 + q) * 8) * 64 + lane; _Pragma("unroll") for (int i = 0; i < 8; ++i) abn[i] = __builtin_nontemporal_load(_s + i * 64); } while (0)
#define RG_SEQ(cc, CS0, CS1) const int _r0 = (cc) * 64; int _q0, _q1; if (_r0 < NCTX) { _q0 = _r0 & ~255; _q1 = _q0 + 256; } else { _q0 = NCTX + ((_r0 - NCTX) & ~2047); _q1 = _q0 + 2048; } const int CS0 = _q0 >> 6, CS1 = _q1 >> 6
#define RG_LOAD_CARRY(cc) do { RG_SEQ(cc, _c0, _c1); const int _nf = (cc) - _c0, _nb = _c1 - 1 - (cc), _nst = _nf > _nb ? _nf : _nb; \
        _Pragma("unroll") for (int k = 0; k < 8; ++k) { const int idx = tid + NTHR * k; cpre[k] = (f32x4){1.f, 0.f, 1.f, 0.f}; \
            if (idx < _nst * 128) { const int i = idx >> 7, u = idx & 127, d = u >> 6, ch = (u & 63) * 2; const int c2 = d == 0 ? _c0 + i : _c1 - 1 - i; const bool valid = d == 0 ? (c2 < (cc)) : (c2 > (cc)); \
                if (valid) cpre[k] = *(const f32x4*)(summ + ((size_t)(d * NCHUNK64 + c2) * 8 + head) * 128 + ch); } } } while (0)
    if (jb < NCHUNK64) { RG_LOAD_AB(jb); RG_LOAD_CARRY(jb); }
    for (int c = jb; c < NCHUNK64; c += nb) {
        const int row0 = c * 64;
        RG_SEQ(c, cs0, cs1);
        v4u ab[8];
#pragma unroll
        for (int i = 0; i < 8; ++i) ab[i] = abn[i];
        { const int nf = c - cs0, nbk = cs1 - 1 - c, nst = nf > nbk ? nf : nbk;
#pragma unroll
          for (int k = 0; k < 8; ++k) { const int idx = tid + NTHR * k; if (idx < nst * 128) { const int i = idx >> 7, u = idx & 127; *(LAS f32x4*)(CARRY + i * 256 + (u >> 6) * 128 + (u & 63) * 2) = cpre[k]; } } }
        if (c + nb < NCHUNK64) { RG_LOAD_AB(c + nb); RG_LOAD_CARRY(c + nb); }
        v4u gyc[2];
        { const v4u* gsrc = (const v4u*)(proj + (size_t)(row0 + (tid >> 3)) * DIN + head * 128 + (tid & 7) * 16); gyc[0] = __builtin_nontemporal_load(gsrc); gyc[1] = __builtin_nontemporal_load(gsrc + 1); }
        __syncthreads();
        float cin[2] = {0.f, 0.f}, cout[2];
        if (row0 >= NCTX) { const int bl = (row0 - NCTX) >> 11;
#pragma unroll
            for (int n = 0; n < 2; ++n) cin[n] = P.in[3][(bl * 2 + dir) * DRG + head * 128 + q * 32 + n * 16 + fr]; }
        { const int my_n = dir == 0 ? c - cs0 : cs1 - 1 - c;
          for (int i = 0; i < my_n; ++i) {
#pragma unroll
              for (int n = 0; n < 2; ++n) { const f32x2 ph = CARRY[i * 256 + dir * 128 + q * 32 + n * 16 + fr]; cin[n] = ph.x * cin[n] + ph.y; } } }
        if (dir == 0) scan_final<false>(ab, HT, cin, cout, fr, fq, q); else scan_final<true>(ab, HT + 64 * XCF_P, cin, cout, fr, fq, q);
        if (row0 < NCTX && fq == 0) { const int bb = row0 >> 8, ci = c & 3;
            if ((dir == 0 && ci == 3) || (dir == 1 && ci == 0)) {
#pragma unroll
                for (int n = 0; n < 2; ++n) P.out[(size_t)MTOK * DM + (bb * 2 + dir) * DRG + head * 128 + q * 32 + n * 16 + fr] = cout[n]; } }
        __syncthreads();
        { const int tl = tid >> 3, c0 = (tid & 7) * 16;
          const v4u g0 = gyc[0], g1 = gyc[1];
          const unsigned gw_[8] = {g0.x, g0.y, g0.z, g0.w, g1.x, g1.y, g1.z, g1.w};
          unsigned ow[8];
#pragma unroll
          for (int e4 = 0; e4 < 4; ++e4) { const f32x4 hf = *(const LAS f32x4*)(HT + tl * XCF_P + c0 + 4 * e4), hb = *(const LAS f32x4*)(HT + (64 + tl) * XCF_P + c0 + 4 * e4);
              const f32x4 hs = hf + hb;
              ow[2 * e4] = pk2(pg8::gelu_tanh(bflo(gw_[2 * e4])) * hs.x, pg8::gelu_tanh(bfhi(gw_[2 * e4])) * hs.y);
              ow[2 * e4 + 1] = pk2(pg8::gelu_tanh(bflo(gw_[2 * e4 + 1])) * hs.z, pg8::gelu_tanh(bfhi(gw_[2 * e4 + 1])) * hs.w); }
          v4u* dst = (v4u*)(mix + (size_t)(row0 + tl) * LD2 + head * 128 + c0);
          dst[0] = (v4u){ow[0], ow[1], ow[2], ow[3]}; dst[1] = (v4u){ow[4], ow[5], ow[6], ow[7]}; }
    }
    __syncthreads();
#undef RG_LOAD_AB
#undef RG_LOAD_CARRY
#undef RG_SEQ
}

constexpr int VT_P = 136;
__device__ __forceinline__ void sgu_phase(const Params& P, LAS unsigned char* lds) {
    const int tid = threadIdx.x, lane = tid & 63, wave = __builtin_amdgcn_readfirstlane(tid >> 6), fr = lane & 15, fq = lane >> 4;
    const bf16* proj = (const bf16*)(P.ws + WS_PROJ);
    bf16* mix = (bf16*)(P.ws + WS_MIX);
    LAS bf16* VT = (LAS bf16*)lds;
    for (int item = blockIdx.x; item < (MTOK / 128) * 8; item += gridDim.x) {
        const int head = item & 7, chunk = item >> 3, rowb = chunk * 128;
        const int p = wave * 16 + fr;
        const size_t tok = (size_t)(rowb + p);
        f32x4 wa[4][2];
#pragma unroll
        for (int ks = 0; ks < 4; ++ks) { const f32x4* src = (const f32x4*)(P.in[16] + (size_t)(head * 128 + p) * 128 + ks * 32 + fq * 8); wa[ks][0] = src[0]; wa[ks][1] = src[1]; }
        v2u uu[8];
#pragma unroll
        for (int n = 0; n < 8; ++n) uu[n] = __builtin_nontemporal_load((const v2u*)(proj + tok * DIN + 2 * DRG + head * 128 + n * 16 + 4 * fq));
        const float bias = P.in[17][head * 128 + p];
        { const int qp = tid >> 3, dg = tid & 7, q0 = 2 * qp;
          const v4u* s0 = (const v4u*)(proj + (size_t)(rowb + q0) * DIN + 3 * DRG + head * 128 + dg * 16);
          const v4u* s1 = (const v4u*)(proj + (size_t)(rowb + q0 + 1) * DIN + 3 * DRG + head * 128 + dg * 16);
          const v4u a0 = __builtin_nontemporal_load(s0), a1 = __builtin_nontemporal_load(s0 + 1), b0 = __builtin_nontemporal_load(s1), b1 = __builtin_nontemporal_load(s1 + 1);
          const unsigned aw[8] = {a0.x, a0.y, a0.z, a0.w, a1.x, a1.y, a1.z, a1.w}, bw[8] = {b0.x, b0.y, b0.z, b0.w, b1.x, b1.y, b1.z, b1.w};
#pragma unroll
          for (int e2 = 0; e2 < 8; ++e2) {
              *(LAS unsigned*)(VT + (dg * 16 + 2 * e2) * VT_P + q0) = pk2(pg8::gelu_tanh(bflo(aw[e2])), pg8::gelu_tanh(bflo(bw[e2])));
              *(LAS unsigned*)(VT + (dg * 16 + 2 * e2 + 1) * VT_P + q0) = pk2(pg8::gelu_tanh(bfhi(aw[e2])), pg8::gelu_tanh(bfhi(bw[e2]))); } }
        __syncthreads();
        bf16x8 A[4];
#pragma unroll
        for (int ks = 0; ks < 4; ++ks) { const f32x4 w0 = wa[ks][0], w1 = wa[ks][1];
            v4u t; t.x = pk2(w0.x, w0.y); t.y = pk2(w0.z, w0.w); t.z = pk2(w1.x, w1.y); t.w = pk2(w1.z, w1.w); A[ks] = __builtin_bit_cast(bf16x8, t); }
#pragma unroll
        for (int n = 0; n < 8; ++n) { f32x4 acc = (f32x4){0.f, 0.f, 0.f, 0.f};
#pragma unroll
            for (int ks = 0; ks < 4; ++ks) { const bf16x8 b = *(const LAS bf16x8*)(VT + (n * 16 + fr) * VT_P + ks * 32 + fq * 8); acc = __builtin_amdgcn_mfma_f32_16x16x32_bf16(b, A[ks], acc, 0, 0, 0); }
            const int d0 = n * 16 + 4 * fq;
            v2u o; o.x = pk2(pg8::gelu_tanh(bflo(uu[n].x)) * (acc.x + bias), pg8::gelu_tanh(bfhi(uu[n].x)) * (acc.y + bias));
            o.y = pk2(pg8::gelu_tanh(bflo(uu[n].y)) * (acc.z + bias), pg8::gelu_tanh(bfhi(uu[n].y)) * (acc.w + bias));
            *(v2u*)(mix + tok * LD2 + DRG + head * 128 + d0) = o; }
        __syncthreads();
    }
}

#define XB_TMO      128
#define XB_XCNT(j)  (256  + 64 * (j))
#define XB_XSUB(j)  (1280 + 64 * (j))
#define XB_XGEN(j)  (2304 + 64 * (j))
#define XB_TOP      3328
#define XB_TOPGEN   3392
#define XCD_BAR_WORDS 3456
#define XB_SPIN_CAP (1u << 18)

__device__ __forceinline__ unsigned xb_ld(unsigned* p)              { return __hip_atomic_load(p, __ATOMIC_RELAXED, __HIP_MEMORY_SCOPE_AGENT); }
__device__ __forceinline__ unsigned xb_add(unsigned* p, unsigned v) { return __hip_atomic_fetch_add(p, v, __ATOMIC_RELAXED, __HIP_MEMORY_SCOPE_AGENT); }
__device__ __forceinline__ unsigned xb_xcc_id() { return (unsigned)__builtin_amdgcn_s_getreg((3 << 11) | 20) & 0xFu; }
#define XB_SPIN(cond, bar) do { unsigned _sp = 0; while (cond) { __builtin_amdgcn_s_sleep(1); \
    if ((++_sp & 255u) == 0u) { if (xb_ld(&(bar)[XB_TMO])) break; if (_sp > XB_SPIN_CAP) { atomicAdd(&(bar)[XB_TMO], 1u); break; } } } } while (0)

struct XcdBarrier {
    unsigned* bar; unsigned x;
    volatile LAS unsigned* st;
};

__device__ __forceinline__ XcdBarrier xcd_barrier_post(unsigned* bar, volatile LAS unsigned* st) {
    XcdBarrier b; b.bar = bar; b.x = xb_xcc_id(); b.st = st;
    if (threadIdx.x == 0) (void)xb_add(&bar[XB_XCNT(b.x)], 1u);
    return b;
}
__device__ __forceinline__ void xcd_barrier_complete(unsigned* bar, unsigned x, unsigned& nloc, unsigned& nx) {
    const unsigned G = gridDim.x * gridDim.y * gridDim.z;
    unsigned sum, cnt, mine, sp = 0u;
    for (;;) {
        sum = 0u; cnt = 0u; mine = 0u;
#pragma unroll
        for (unsigned j = 0; j < 16; ++j) { const unsigned c = xb_ld(&bar[XB_XCNT(j)]); sum += c; cnt += (c > 0u) ? 1u : 0u; mine = (j == x) ? c : mine; }
        if (sum == G) break;
        __builtin_amdgcn_s_sleep(1);
        if ((++sp & 255u) == 0u) { if (xb_ld(&bar[XB_TMO])) break; if (sp > XB_SPIN_CAP) { atomicAdd(&bar[XB_TMO], 1u); break; } }
    }
    nloc = mine > 0u ? mine : 1u; nx = cnt > 0u ? cnt : 1u;
}

__device__ __forceinline__ void xcd_barrier(const XcdBarrier& b) {
    asm volatile("s_waitcnt vmcnt(0)" ::: "memory");
    __syncthreads();
    if (threadIdx.x == 0) {
        unsigned* bar = b.bar;
        __builtin_amdgcn_s_waitcnt(0);
        unsigned nloc = b.st[0], nx = b.st[1];
        if (nloc == 0u) { xcd_barrier_complete(bar, b.x, nloc, nx); b.st[0] = nloc; b.st[1] = nx; }
        const unsigned old = xb_add(&bar[XB_XSUB(b.x)], 1u);
        const unsigned gen = old / nloc;
        if (old + 1u == (gen + 1u) * nloc) {
            __builtin_amdgcn_fence(__ATOMIC_RELEASE, "agent");
            asm volatile("s_waitcnt vmcnt(0)" ::: "memory");
            const unsigned og = xb_add(&bar[XB_TOP], 1u);
            const unsigned tg = og / nx;
            if (og + 1u == (tg + 1u) * nx) xb_add(&bar[XB_TOPGEN], 1u);
            else XB_SPIN(xb_ld(&bar[XB_TOPGEN]) == tg, bar);
            __builtin_amdgcn_fence(__ATOMIC_ACQUIRE, "agent");
            xb_add(&bar[XB_XGEN(b.x)], 1u);
            asm volatile("s_waitcnt vmcnt(0)" ::: "memory");
        } else {
            XB_SPIN(xb_ld(&bar[XB_XGEN(b.x)]) == gen, bar);
            __builtin_amdgcn_fence(__ATOMIC_ACQUIRE, "agent");
            asm volatile("s_waitcnt vmcnt(0)" ::: "memory");
        }
    }
    __syncthreads();
}

constexpr int N_PHASES = 10;
__global__ void __launch_bounds__(NTHR, 2) mk_fwd(Params P) {
    extern __shared__ __attribute__((aligned(16))) unsigned char lds_raw[];
    LAS unsigned char* lds = (LAS unsigned char*)lds_raw;
    cg::grid_group grid = cg::this_grid();
    const int lo = P.ph_lo, hi = P.ph_hi, G = gridDim.x;
    unsigned char* ws = P.ws;
#define IN(k) (lo <= (k) && (k) < hi)
    volatile LAS unsigned* bst = (volatile LAS unsigned*)(lds + 131072 + 64);
    if (threadIdx.x < 2) bst[threadIdx.x] = 0u;
    __syncthreads();
    XcdBarrier xbar; xbar.bar = (unsigned*)ws; xbar.x = 0; xbar.st = bst;
    if (hi - lo > 1) xbar = xcd_barrier_post((unsigned*)ws, bst);
    if (lo < 0) grid.sync();
#define SEAM(k) do { if (IN(k) && IN((k) + 1)) xcd_barrier(xbar); } while (0)
    if (IN(0)) { phase0(P, lds); __syncthreads(); }
    if (IN(0) && IN(1)) gemv_wait(P);
    if (IN(1)) norm_mod_phase<1>(P);
    SEAM(1);
    if (IN(2)) { pg8::Gemm g{(const bf16*)(ws + WS_H), (const bf16*)(ws + WS_WIN), MTOK, DIN, DM, LD2}; pg8::StaticOrder S; S.init(MTOK, DIN, DM, G, (int)blockIdx.x);
        pg8::EpiProj E{(bf16*)(ws + WS_PROJ), DIN};
        pg8::gemm_phase<pg8::EpiProj, pg8::StaticOrder, true, true>(lds, g, S, E); }
    SEAM(2);
    if (IN(3)) { rg_phase1(P, lds); if (IN(4)) head_publish(P); sgu_phase(P, lds); }
    if (IN(3) && IN(4)) head_wait(P);
    if (IN(4)) rg_phase2(P, lds);
    SEAM(4);
    if (IN(5)) { pg8::Gemm g{(const bf16*)(ws + WS_MIX), (const bf16*)(ws + WS_WOUT), MTOK, DM, DM, LD2}; pg8::SplitOrder S; S.init(DM, G, (int)blockIdx.x);
        pg8::EpiDelta E{(bf16*)(ws + WS_D1), (bf16*)(ws + WS_PART), (const float*)(ws + WS_MOD) + 2 * DM};
        pg8::gemm_phase<pg8::EpiDelta, pg8::SplitOrder, true, true>(lds, g, S, E); }
    SEAM(5);
    if (IN(6)) norm_mod_phase<2>(P);
    SEAM(6);
    if (IN(7)) { pg8::Gemm g{(const bf16*)(ws + WS_H), (const bf16*)(ws + WS_WFF1), MTOK, DFF, DM, LD2}; pg8::StaticOrder S; S.init(MTOK, DFF, DM, G, (int)blockIdx.x);
        pg8::EpiRelu2 E{(bf16*)(ws + WS_F), LD8};
        pg8::gemm_phase<pg8::EpiRelu2, pg8::StaticOrder, false, true>(lds, g, S, E); }
    SEAM(7);
    if (IN(8)) { pg8::Gemm g{(const bf16*)(ws + WS_F), (const bf16*)(ws + WS_WFF2), MTOK, DM, DFF, LD8}; pg8::SplitOrder S; S.init(DFF, G, (int)blockIdx.x);
        pg8::EpiDelta E{(bf16*)(ws + WS_D2), (bf16*)(ws + WS_PART), (const float*)(ws + WS_MOD) + 5 * DM};
        pg8::gemm_phase<pg8::EpiDelta, pg8::SplitOrder, true, true>(lds, g, S, E); }
    SEAM(8);
    if (IN(9)) final_norm_phase(P, P.out);
#undef IN
#undef SEAM
}

extern "C" void kernel_launch(void* const* d_in, const int* in_sizes, int n_in, void* d_out, int out_size, void* d_ws, size_t ws_size, hipStream_t stream) {
    static int grid = 0;
    if (grid == 0) {
        if (n_in != 23 || ws_size < WS_END) { fprintf(stderr, "kernel_launch: unexpected n_in %d / ws_size %zu\n", n_in, ws_size); grid = -1; return; }
        int dev = 0, cus = 0, per_cu = 0;
        (void)hipGetDevice(&dev); (void)hipDeviceGetAttribute(&cus, hipDeviceAttributeMultiprocessorCount, dev);
        if (hipFuncSetAttribute((const void*)mk_fwd, hipFuncAttributeMaxDynamicSharedMemorySize, LDS_BYTES) != hipSuccess) { fprintf(stderr, "kernel_launch: hipFuncSetAttribute failed\n"); grid = -1; return; }
        if (hipOccupancyMaxActiveBlocksPerMultiprocessor(&per_cu, (const void*)mk_fwd, NTHR, LDS_BYTES) != hipSuccess || per_cu < 1) fprintf(stderr, "kernel_launch: occupancy query says %d\n", per_cu);
        (void)hipGetLastError();
        grid = cus > 0 ? cus : 256;
        if (grid > 256) grid = 256;
        grid &= ~7;
    }
    if (grid < 0) return;
    Params p{};
    for (int i = 0; i < 23; ++i) p.in[i] = (const float*)d_in[i];
    p.out = (float*)d_out; p.ws = (unsigned char*)d_ws;
    p.ph_lo = 0; p.ph_hi = N_PHASES;
    if (hipMemsetAsync(d_ws, 0, 16384, stream) != hipSuccess) { fprintf(stderr, "kernel_launch: memset of the barrier words failed\n"); return; }
    void* args[] = {&p};
    hipError_t e = hipLaunchCooperativeKernel((const void*)mk_fwd, dim3(grid), dim3(NTHR), args, LDS_BYTES, stream);
    if (e != hipSuccess) fprintf(stderr, "cooperative launch failed: %s (grid %d)\n", hipGetErrorString(e), grid);
}
```

```cpp
#include <hip/hip_runtime.h>
#include <hip/hip_cooperative_groups.h>
#include <cstdio>
#include <cstdint>
namespace cg = cooperative_groups;
namespace pg8 {
#define PG8_LAS __attribute__((address_space(3)))
typedef unsigned short bf16_t;
typedef short bf16x8 __attribute__((ext_vector_type(8)));
typedef float f32x4 __attribute__((ext_vector_type(4)));
typedef unsigned u32x4 __attribute__((ext_vector_type(4)));
constexpr int BM = 256, BK = 64, HALF = 128, HTB = HALF * BK * 2  , STAGE_BYTES = 8 * HTB, NXCD = 8, WGM = 8;

__host__ __device__ __forceinline__ int lds_byte(int r, int c) { const int st = (r >> 4) * 2 + (c >> 5), rr = r & 15, cc = c & 31, ob = rr * 64 + cc * 2; return st * 1024 + (ob ^ (((ob >> 9) & 1) << 5)); }
__host__ __device__ __forceinline__ void stage_rc(int b, int& R, int& C) { const int st = b / 1024, sb = b % 1024, swz = sb ^ (((sb >> 9) & 1) << 5); R = (st >> 1) * 16 + swz / 64; C = (st & 1) * 32 + (swz % 64) / 2; }
__host__ __device__ __forceinline__ int perm32(int rho) { const int n = rho >> 4, i = rho & 15; return 8 * (i >> 2) + 4 * n + (i & 3); }

struct Unit { int pm, pn, k0, nt, part; };
struct Gemm { const bf16_t* A; const bf16_t* Bt; int M, N, K, ld; };

struct StaticOrder {
    int nM, nN, nwg, G, c, ntk;
    __host__ __device__ void init(int M, int N, int K, int G_, int c_) { nM = M / BM; nN = N / BM; nwg = nM * nN; G = G_; c = c_; ntk = K / BK; }
    __host__ __device__ bool next(int i, Unit& u) const {
        const long L = (long)i * G + c; if (L >= nwg) return false;
        int wgid = (int)L; { const int q = nwg / NXCD, r = nwg % NXCD, xcd = wgid % NXCD, off = wgid / NXCD; wgid = (xcd < r ? xcd * (q + 1) : r * (q + 1) + (xcd - r) * q) + off; }
        const int nig = WGM * nN, gid = wgid / nig, fm = gid * WGM, gsz = (nM - fm) < WGM ? (nM - fm) : WGM;
        u.pm = fm + ((wgid % nig) % gsz); u.pn = (wgid % nig) / gsz; u.k0 = 0; u.nt = ntk; u.part = 0; return true;
    }
    __device__ __forceinline__ void a_ready(const Unit&) const {}
    __device__ __forceinline__ void done(const Unit&) const {}
};
__device__ __forceinline__ unsigned cvt_pk_bf16(float lo, float hi) { unsigned r; asm volatile("v_cvt_pk_bf16_f32 %0, %1, %2" : "=v"(r) : "v"(lo), "v"(hi)); return r; }
__device__ __forceinline__ float gelu_tanh(float x) {
    const float u = x * (0.7978845608f + 0.0356774081f * x * x);
    const float e = __builtin_amdgcn_exp2f(-2.885390082f * u);
    return x * __builtin_amdgcn_rcpf(1.0f + e);
}
struct EpiProj {
    static constexpr bool PERM = true, AFTER_DRAIN = false;
    bf16_t* O; int ldc;
    __device__ __forceinline__ void operator()(const f32x4 (&acc)[2][2][4][2], const Unit& u, int wr, int wc, int fr, int fq) const {
        const int row0 = u.pm * BM + wr * 64 + fr, col0 = u.pn * BM + wc * 32 + 8 * fq;
#pragma unroll
        for (int ai = 0; ai < 2; ++ai)
#pragma unroll
            for (int m = 0; m < 4; ++m) { bf16_t* rowp = O + (size_t)(row0 + ai * HALF + m * 16) * ldc + col0;
#pragma unroll
                for (int bj = 0; bj < 2; ++bj) { const f32x4 v0 = acc[ai][bj][m][0], v1 = acc[ai][bj][m][1];
                    u32x4 w; w.x = cvt_pk_bf16(v0[0], v0[1]); w.y = cvt_pk_bf16(v0[2], v0[3]); w.z = cvt_pk_bf16(v1[0], v1[1]); w.w = cvt_pk_bf16(v1[2], v1[3]);
                    *(u32x4*)(rowp + bj * HALF) = w; } }
    }
};
struct EpiRelu2 {
    static constexpr bool PERM = true, AFTER_DRAIN = false;
    bf16_t* O; int ldc;
    __device__ __forceinline__ void operator()(const f32x4 (&acc)[2][2][4][2], const Unit& u, int wr, int wc, int fr, int fq) const {
        const int row0 = u.pm * BM + wr * 64 + fr, col0 = u.pn * BM + wc * 32 + 8 * fq;
#pragma unroll
        for (int ai = 0; ai < 2; ++ai)
#pragma unroll
            for (int m = 0; m < 4; ++m) { bf16_t* rowp = O + (size_t)(row0 + ai * HALF + m * 16) * ldc + col0;
#pragma unroll
                for (int bj = 0; bj < 2; ++bj) { f32x4 v0 = acc[ai][bj][m][0], v1 = acc[ai][bj][m][1];
#pragma unroll
                    for (int j = 0; j < 4; ++j) { const float a = fmaxf(v0[j], 0.f), b = fmaxf(v1[j], 0.f); v0[j] = a * a; v1[j] = b * b; }
                    u32x4 w; w.x = cvt_pk_bf16(v0[0], v0[1]); w.y = cvt_pk_bf16(v0[2], v0[3]); w.z = cvt_pk_bf16(v1[0], v1[1]); w.w = cvt_pk_bf16(v1[2], v1[3]);
                    __builtin_nontemporal_store(w, (u32x4*)(rowp + bj * HALF)); } }
    }
};
struct SplitOrder {
    int G, c, ntk;
    __host__ __device__ void init(int K, int G_, int c_) { G = G_; c = c_; ntk = K / BK; }
    __host__ __device__ bool next(int i, Unit& u) const {
        const long L = (long)i * G + c; if (L >= 512) return false;
        if (L < 256) { const int xcd = (int)L & 7, off = (int)L >> 3;
            u.pm = xcd * 4 + (off & 3); u.pn = off >> 2; u.k0 = 0; u.nt = ntk; u.part = 0; return true; }
        const int hl = (int)L - 256, x = hl & 7, off = hl >> 3, pr = x >> 1, kh = x & 1;
        u.pm = 32 + pr * 4 + (off & 3); u.pn = off >> 2; u.k0 = kh * (ntk / 2) * BK; u.nt = ntk / 2; u.part = kh; return true;
    }
    __device__ __forceinline__ void a_ready(const Unit&) const {}
    __device__ __forceinline__ void done(const Unit&) const {}
};
struct EpiRes {
    static constexpr bool PERM = false, AFTER_DRAIN = false;
    const float* base0; const float* base1; float* out; const float* gate; float* part;
    __device__ __forceinline__ void operator()(const f32x4 (&acc)[2][2][4][2], const Unit& u, int wr, int wc, int fr, int fq) const {
        const int row0 = u.pm * BM + wr * 64 + fr, col0 = u.pn * BM + wc * 32 + 4 * fq;
        const int cond = u.pm < 16 ? 0 : 1 + ((u.pm - 16) >> 3);
        const float* gp = gate + cond * 12288 + col0;
        const float* bb = u.pm < 16 ? base0 + (size_t)row0 * 2048 + col0 : base1 + (size_t)(row0 - 4096) * 2048 + col0;
        float* ob = out + (size_t)row0 * 2048 + col0;
        float* pb = part + ((size_t)row0 - 8192) * 2048 + col0;
        f32x4 gv[2][2];
#pragma unroll
        for (int bj = 0; bj < 2; ++bj)
#pragma unroll
            for (int n = 0; n < 2; ++n) gv[bj][n] = *(const f32x4*)(gp + bj * HALF + n * 16);
#pragma unroll
        for (int ai = 0; ai < 2; ++ai)
#pragma unroll
            for (int m = 0; m < 4; ++m) { const size_t ro = (size_t)(ai * HALF + m * 16) * 2048;
#pragma unroll
                for (int bj = 0; bj < 2; ++bj)
#pragma unroll
                    for (int n = 0; n < 2; ++n) {
                        if (u.part) *(f32x4*)(pb + ro + bj * HALF + n * 16) = gv[bj][n] * acc[ai][bj][m][n];
                        else { const f32x4 b = *(const f32x4*)(bb + ro + bj * HALF + n * 16); *(f32x4*)(ob + ro + bj * HALF + n * 16) = b + gv[bj][n] * acc[ai][bj][m][n]; } }
                asm volatile("" ::: "memory"); }
    }
};
struct EpiDelta {
    static constexpr bool PERM = true, AFTER_DRAIN = false;
    bf16_t* D; bf16_t* Dpart; const float* gate;
    __device__ __forceinline__ void operator()(const f32x4 (&acc)[2][2][4][2], const Unit& u, int wr, int wc, int fr, int fq) const {
        const int row0 = u.pm * BM + wr * 64 + fr, col0 = u.pn * BM + wc * 32 + 8 * fq;
        const int cond = u.pm < 16 ? 0 : 1 + ((u.pm - 16) >> 3);
        const float* gp = gate + cond * 12288 + col0;
        f32x4 g0[2], g1[2];
#pragma unroll
        for (int bj = 0; bj < 2; ++bj) { g0[bj] = *(const f32x4*)(gp + bj * HALF); g1[bj] = *(const f32x4*)(gp + bj * HALF + 4); }
        bf16_t* base = (u.part ? Dpart + ((long)row0 - 8192) * 2048 : D + (long)row0 * 2048) + col0;
#pragma unroll
        for (int ai = 0; ai < 2; ++ai)
#pragma unroll
            for (int m = 0; m < 4; ++m) { bf16_t* rowp = base + (long)(ai * HALF + m * 16) * 2048;
#pragma unroll
                for (int bj = 0; bj < 2; ++bj) { const f32x4 v0 = acc[ai][bj][m][0] * g0[bj], v1 = acc[ai][bj][m][1] * g1[bj];
                    u32x4 w; w.x = cvt_pk_bf16(v0[0], v0[1]); w.y = cvt_pk_bf16(v0[2], v0[3]); w.z = cvt_pk_bf16(v1[0], v1[1]); w.w = cvt_pk_bf16(v1[2], v1[3]);
                    *(u32x4*)(rowp + bj * HALF) = w; } }
    }
};
template <class Epi, class Sched, bool ALIGN_EPI = false, bool SP2 = false>
__device__ __forceinline__ void gemm_phase(PG8_LAS unsigned char* lds, const Gemm g, const Sched& S, const Epi& E) {
    const int tid = threadIdx.x, wid = __builtin_amdgcn_readfirstlane(tid >> 6), lane = tid & 63, wr = wid >> 2, wc = wid & 3, fr = lane & 15, fq = lane >> 4;
    const int K = g.ld;
    unsigned voffA[2], voffB[2];
#pragma unroll
    for (int i = 0; i < 2; ++i) { int R, C; stage_rc(tid * 16 + i * 8192, R, C); const int Rb = Epi::PERM ? ((R & ~31) + perm32(R & 31)) : R;
        voffA[i] = (unsigned)(R * K + C) * 2u; voffB[i] = (unsigned)(Rb * K + C) * 2u; }
    const size_t kstep = (size_t)(BK * 2);
    const size_t hstep = (size_t)HALF * K * 2;
    const size_t tstep = 2 * hstep;
    const unsigned ldsw = (unsigned)wid * 1024u;
    const int aoff = lds_byte(wr * 64 + fr, fq * 8), boff = lds_byte(wc * 32 + fr, fq * 8);
#define PG8_SA(b, h) (((b) * 2 + (h)) * HTB)
#define PG8_SB(b, h) ((4 + (b) * 2 + (h)) * HTB)
#define PG8_STAGE(bufoff, gbase, voff) do { _Pragma("unroll") for (int _i = 0; _i < 2; ++_i) \
        __builtin_amdgcn_global_load_lds((const unsigned*)((const char*)(gbase) + (voff)[_i]), (PG8_LAS unsigned*)(lds + (bufoff) + ldsw + _i * 8192), 16, 0, 0); } while (0)
#define PG8_LDA(dst, b, h) do { _Pragma("unroll") for (int m = 0; m < 4; ++m) _Pragma("unroll") for (int k = 0; k < 2; ++k) dst[m][k] = *(const PG8_LAS bf16x8*)(lds + PG8_SA(b, h) + aoff + m * 2048 + k * 1024); } while (0)
#define PG8_LDB(dst, b, h) do { _Pragma("unroll") for (int n = 0; n < 2; ++n) _Pragma("unroll") for (int k = 0; k < 2; ++k) dst[n][k] = *(const PG8_LAS bf16x8*)(lds + PG8_SB(b, h) + boff + n * 2048 + k * 1024); } while (0)
#define PG8_MMA(ai, bj, At, Bt) do { __builtin_amdgcn_s_setprio(1); _Pragma("unroll") for (int m = 0; m < 4; ++m) _Pragma("unroll") for (int n = 0; n < 2; ++n) _Pragma("unroll") for (int k = 0; k < 2; ++k) \
        acc[ai][bj][m][n] = __builtin_amdgcn_mfma_f32_16x16x32_bf16(Bt[n][k], At[m][k], acc[ai][bj][m][n], 0, 0, 0); __builtin_amdgcn_s_setprio(0); } while (0)
#define PG8_WAIT_V(n) asm volatile("s_waitcnt vmcnt(" #n ")" ::: "memory")
#define PG8_WAIT_L(n) asm volatile("s_waitcnt lgkmcnt(" #n ")" ::: "memory")
#define PG8_BAR __builtin_amdgcn_s_barrier()
#define PG8_SCHED __builtin_amdgcn_sched_barrier(0)
    Unit cur, nxt; int ui = 0;
    if (!S.next(0, cur)) return;
    f32x4 acc[2][2][4][2];
#pragma unroll
    for (int a = 0; a < 2; ++a)
#pragma unroll
        for (int b = 0; b < 2; ++b)
#pragma unroll
            for (int m = 0; m < 4; ++m)
#pragma unroll
                for (int n = 0; n < 2; ++n) acc[a][b][m][n] = (f32x4){0.f, 0.f, 0.f, 0.f};
    bf16x8 At[4][2], B0[2][2], B1[2][2];
    const char* cA = (const char*)g.A + (size_t)cur.pm * tstep + (size_t)cur.k0 * 2; const char* cB = (const char*)g.Bt + (size_t)cur.pn * tstep + (size_t)cur.k0 * 2;
    S.a_ready(cur);
    if constexpr (SP2) {
        PG8_STAGE(PG8_SB(0, 0), cB, voffB); PG8_STAGE(PG8_SB(0, 1), cB + hstep, voffB); PG8_STAGE(PG8_SA(0, 0), cA, voffA); PG8_STAGE(PG8_SA(0, 1), cA + hstep, voffA);
        if (wr == 1) PG8_BAR;
        PG8_WAIT_V(2); PG8_BAR;
        PG8_STAGE(PG8_SB(1, 0), cB + kstep, voffB); PG8_STAGE(PG8_SA(1, 0), cA + kstep, voffA); PG8_STAGE(PG8_SB(1, 1), cB + hstep + kstep, voffB);
        PG8_WAIT_V(6); PG8_BAR;
    } else {
        PG8_STAGE(PG8_SB(0, 0), cB, voffB); PG8_STAGE(PG8_SA(0, 0), cA, voffA); PG8_STAGE(PG8_SB(0, 1), cB + hstep, voffB); PG8_STAGE(PG8_SA(0, 1), cA + hstep, voffA);
        if (wr == 1) PG8_BAR;
        PG8_WAIT_V(4); PG8_BAR;
        PG8_STAGE(PG8_SB(1, 0), cB + kstep, voffB); PG8_STAGE(PG8_SA(1, 0), cA + kstep, voffA); PG8_STAGE(PG8_SB(1, 1), cB + hstep + kstep, voffB);
        PG8_WAIT_V(6); PG8_BAR;
    }
    for (;;) {
        const bool has_next = S.next(ui + 1, nxt);
        const char* nA = has_next ? (const char*)g.A + (size_t)nxt.pm * tstep + (size_t)nxt.k0 * 2 : cA; const char* nB = has_next ? (const char*)g.Bt + (size_t)nxt.pn * tstep + (size_t)nxt.k0 * 2 : cB;
        const int nt = cur.nt;
        for (int t = 0; t < nt; t += 2) {
            const bool last = (t == nt - 2);
            const char* a1 = cA + (size_t)(t + 1) * kstep;
            const char* a2 = last ? nA : cA + (size_t)(t + 2) * kstep; const char* b2 = last ? nB : cB + (size_t)(t + 2) * kstep;
            const char* a3 = a2 + kstep; const char* b3 = b2 + kstep;
            if (last && has_next) S.a_ready(nxt);
            if constexpr (SP2) {
            PG8_LDB(B0, 0, 0); PG8_LDB(B1, 0, 1); PG8_SCHED; PG8_LDA(At, 0, 0); PG8_STAGE(PG8_SA(1, 1), a1 + hstep, voffA);
            PG8_WAIT_V(8); PG8_WAIT_L(0); PG8_BAR; PG8_MMA(0, 0, At, B0); PG8_MMA(0, 1, At, B1); PG8_BAR; PG8_SCHED;
            PG8_LDA(At, 0, 1); PG8_STAGE(PG8_SB(0, 0), b2, voffB); PG8_STAGE(PG8_SB(0, 1), b2 + hstep, voffB); PG8_STAGE(PG8_SA(0, 0), a2, voffA);
            PG8_WAIT_V(8); PG8_WAIT_L(0); PG8_BAR; PG8_MMA(1, 0, At, B0); PG8_MMA(1, 1, At, B1); PG8_BAR; PG8_SCHED;
            PG8_LDB(B0, 1, 0); PG8_LDB(B1, 1, 1); PG8_SCHED; PG8_LDA(At, 1, 0); PG8_STAGE(PG8_SA(0, 1), a2 + hstep, voffA);
            PG8_WAIT_V(8); PG8_WAIT_L(0); PG8_BAR; PG8_MMA(0, 0, At, B0); PG8_MMA(0, 1, At, B1); PG8_BAR; PG8_SCHED;
            PG8_LDA(At, 1, 1); PG8_STAGE(PG8_SB(1, 0), b3, voffB); PG8_STAGE(PG8_SB(1, 1), b3 + hstep, voffB); PG8_STAGE(PG8_SA(1, 0), a3, voffA);
            PG8_WAIT_V(8); PG8_WAIT_L(0); PG8_BAR; PG8_MMA(1, 0, At, B0); PG8_MMA(1, 1, At, B1); PG8_BAR; PG8_SCHED;
            } else {
            PG8_LDB(B0, 0, 0); PG8_SCHED; PG8_LDA(At, 0, 0); PG8_STAGE(PG8_SA(1, 1), a1 + hstep, voffA);
            PG8_WAIT_L(8); PG8_BAR; PG8_WAIT_L(0); PG8_MMA(0, 0, At, B0); PG8_BAR; PG8_SCHED;
            PG8_LDB(B1, 0, 1); PG8_STAGE(PG8_SB(0, 0), b2, voffB);
            PG8_BAR; PG8_WAIT_L(0); PG8_MMA(0, 1, At, B1); PG8_BAR;
            PG8_LDA(At, 0, 1); PG8_STAGE(PG8_SA(0, 0), a2, voffA);
            PG8_BAR; PG8_WAIT_L(0); PG8_MMA(1, 0, At, B0); PG8_BAR; PG8_SCHED;
            PG8_STAGE(PG8_SB(0, 1), b2 + hstep, voffB);
            PG8_WAIT_V(6); PG8_BAR; PG8_MMA(1, 1, At, B1); PG8_BAR;
            PG8_LDB(B0, 1, 0); PG8_SCHED; PG8_LDA(At, 1, 0); PG8_STAGE(PG8_SA(0, 1), a2 + hstep, voffA);
            PG8_WAIT_L(8); PG8_BAR; PG8_WAIT_L(0); PG8_MMA(0, 0, At, B0); PG8_BAR; PG8_SCHED;
            PG8_LDB(B1, 1, 1); PG8_STAGE(PG8_SB(1, 0), b3, voffB);
            PG8_BAR; PG8_WAIT_L(0); PG8_MMA(0, 1, At, B1); PG8_BAR;
            PG8_LDA(At, 1, 1); PG8_STAGE(PG8_SA(1, 0), a3, voffA);
            PG8_BAR; PG8_WAIT_L(0); PG8_MMA(1, 0, At, B0); PG8_BAR; PG8_SCHED;
            PG8_STAGE(PG8_SB(1, 1), b3 + hstep, voffB);
            PG8_WAIT_V(6); PG8_BAR; PG8_MMA(1, 1, At, B1); PG8_BAR;
            }
        }
        if constexpr (ALIGN_EPI) { if (wr == 0) PG8_BAR; }
        if constexpr (!Epi::AFTER_DRAIN) { E(acc, cur, wr, wc, fr, fq); S.done(cur); }
        if (!has_next) break;
#pragma unroll
        for (int a = 0; a < 2; ++a)
#pragma unroll
            for (int b = 0; b < 2; ++b)
#pragma unroll
                for (int m = 0; m < 4; ++m)
#pragma unroll
                    for (int n = 0; n < 2; ++n) acc[a][b][m][n] = (f32x4){0.f, 0.f, 0.f, 0.f};
        cur = nxt; cA = nA; cB = nB; ++ui;
        if constexpr (ALIGN_EPI) { if (wr == 1) PG8_BAR; }
    }
    PG8_WAIT_V(0);
    if constexpr (!ALIGN_EPI) { if (wr == 0) PG8_BAR; }
    PG8_BAR;
    if constexpr (Epi::AFTER_DRAIN) { E.fused(acc, cur, wr, wc, fr, fq, lds, wid, lane); S.done(cur); }
#undef PG8_SA
#undef PG8_SB
#undef PG8_STAGE
#undef PG8_LDA
#undef PG8_LDB
#undef PG8_MMA
#undef PG8_WAIT_V
#undef PG8_WAIT_L
#undef PG8_BAR
#undef PG8_SCHED
}
}

constexpr int DM = 2048, NCTX = 4096, NLAT = 8192, MTOK = NCTX + NLAT, DRG = 1024, DIN = 4096, DFF = 8192, NMOD6 = 12288, NCOND = 5;
constexpr int NCHUNK64 = MTOK / 64;
constexpr float EPSN = 1e-6f;
constexpr size_t MiB = 1u << 20;
constexpr size_t WS_MOD = 1 * MiB;
constexpr size_t WS_GWT = 2 * MiB;
constexpr size_t WS_SUMM = 4 * MiB;
constexpr int LD2 = DM + 64, LD8 = DFF + 64;
constexpr size_t WS_WFF2 = 8 * MiB;
constexpr size_t WS_WIN = 41 * MiB;
constexpr size_t WS_WOUT = 58 * MiB;
constexpr size_t WS_WFF1 = 67 * MiB;
constexpr size_t WS_H = 100 * MiB;
constexpr size_t WS_PROJ = 150 * MiB;
constexpr size_t WS_MIX = 246 * MiB;
constexpr size_t WS_F = 150 * MiB;
constexpr size_t WS_PART = 344 * MiB;
constexpr size_t WS_D1 = WS_PROJ;
constexpr size_t WS_AB0 = WS_H;
constexpr size_t WS_AB1 = 296 * MiB;
constexpr size_t WS_D2 = WS_H;
constexpr size_t WS_X1A = 41 * MiB;
constexpr size_t WS_X1B = 360 * MiB;
constexpr size_t WS_END = 384 * MiB;
static_assert(WS_WFF2 + (size_t)DM * LD8 * 2 <= WS_WIN && WS_WIN + (size_t)DIN * LD2 * 2 <= WS_WOUT && WS_WOUT + (size_t)DM * LD2 * 2 <= WS_WFF1 && WS_WFF1 + (size_t)DFF * LD2 * 2 <= WS_H &&
              WS_H + (size_t)MTOK * LD2 * 2 <= WS_PROJ && WS_PROJ + (size_t)MTOK * DIN * 2 <= WS_MIX && WS_MIX + (size_t)MTOK * LD2 * 2 <= WS_PART && WS_F + (size_t)MTOK * LD8 * 2 <= WS_PART &&
              WS_MIX + (size_t)MTOK * LD2 * 2 <= WS_AB1 && WS_AB1 + (size_t)NCHUNK64 * 8 * 4 * 8 * 64 * 16 <= WS_PART && (size_t)NCHUNK64 * 8 * 4 * 8 * 64 * 16 <= (size_t)MTOK * LD2 * 2, "d_ws map");
static_assert(WS_X1A + (size_t)6144 * DM * 2 <= WS_WFF1 && WS_PART + (size_t)4096 * DM * 2 <= WS_X1B && WS_X1B + (size_t)6144 * DM * 2 <= WS_END, "x1 halves");
constexpr int LDS_BYTES = 147456;
constexpr int NWAVES = 8, NTHR = 512;

#define GAS __attribute__((address_space(1)))
#define LAS __attribute__((address_space(3)))
typedef unsigned short bf16;
typedef unsigned v4u __attribute__((ext_vector_type(4)));
typedef unsigned v2u __attribute__((ext_vector_type(2)));
typedef float f32x4 __attribute__((ext_vector_type(4)));
typedef float f32x2 __attribute__((ext_vector_type(2)));
typedef short bf16x8 __attribute__((ext_vector_type(8)));
#define LDS_WAIT() asm volatile("s_waitcnt lgkmcnt(0)" ::: "memory")
__device__ __forceinline__ unsigned pk2(float lo, float hi) { return pg8::cvt_pk_bf16(lo, hi); }
__device__ __forceinline__ float bflo(unsigned u) { return __builtin_bit_cast(float, u << 16); }
__device__ __forceinline__ float bfhi(unsigned u) { return __builtin_bit_cast(float, u & 0xffff0000u); }
__device__ __forceinline__ float wave_sum(float v) {
#pragma unroll
    for (int o = 1; o < 64; o <<= 1) v += __shfl_xor(v, o);
    return v;
}
__device__ __forceinline__ float sigmoidf_(float x) { return __builtin_amdgcn_rcpf(1.0f + __builtin_amdgcn_exp2f(-1.442695041f * x)); }

struct Params {
    const float* in[23];
    float* out; unsigned char* ws;
    int ph_lo, ph_hi;
};

template <bool NT  >
__device__ __forceinline__ void p0_transpose_item(const float* W, int K, int N, bf16* WT, int ldt, LAS float* scr, int item, int lane) {
    const int nblk = N / 32, kb = item / nblk, nb = item % nblk, k0 = 64 * kb, n0 = 32 * nb;
#ifndef P0_UNROLL
#define P0_UNROLL 16
#endif
#pragma unroll
    for (int i0 = 0; i0 < 32; i0 += P0_UNROLL) { float wv[P0_UNROLL];
#pragma unroll
        for (int i = 0; i < P0_UNROLL; ++i) wv[i] = __builtin_nontemporal_load(&W[(size_t)(k0 + 2 * (i0 + i) + (lane >> 5)) * N + n0 + (lane & 31)]);
#pragma unroll
        for (int i = 0; i < P0_UNROLL; ++i) scr[(2 * (i0 + i) + (lane >> 5)) * 33 + (lane & 31)] = wv[i]; }
    LDS_WAIT(); asm volatile("" ::: "memory");
    const int c = lane & 7;
#pragma unroll
    for (int j = 0; j < 4; ++j) { const int n = (lane >> 3) + 8 * j; const LAS float* s = scr + (8 * c) * 33 + n;
        v4u o; o.x = pk2(s[0 * 33], s[1 * 33]); o.y = pk2(s[2 * 33], s[3 * 33]); o.z = pk2(s[4 * 33], s[5 * 33]); o.w = pk2(s[6 * 33], s[7 * 33]);
        if (NT) __builtin_nontemporal_store(o, (v4u*)(WT + (size_t)(n0 + n) * ldt + k0 + 8 * c)); else *(v4u*)(WT + (size_t)(n0 + n) * ldt + k0 + 8 * c) = o; }
    LDS_WAIT(); asm volatile("" ::: "memory");
}
__device__ __forceinline__ void tr_load(const float* Wt  , int N, int lane, float (&wv)[32]) {
#pragma unroll
    for (int i = 0; i < 32; ++i) wv[i] = __builtin_nontemporal_load(&Wt[(size_t)(2 * i + (lane >> 5)) * N + (lane & 31)]);
}
__device__ __forceinline__ void tr_store(bf16* WTt  , int ldt, int lane, const float (&wv)[32], LAS float* scr) {
#pragma unroll
    for (int i = 0; i < 32; ++i) scr[(2 * i + (lane >> 5)) * 33 + (lane & 31)] = wv[i];
    LDS_WAIT(); asm volatile("" ::: "memory");
    const int c = lane & 7;
#pragma unroll
    for (int j = 0; j < 4; ++j) { const int n = (lane >> 3) + 8 * j; const LAS float* s = scr + (8 * c) * 33 + n;
        v4u o; o.x = pk2(s[0 * 33], s[1 * 33]); o.y = pk2(s[2 * 33], s[3 * 33]); o.z = pk2(s[4 * 33], s[5 * 33]); o.w = pk2(s[6 * 33], s[7 * 33]);
        __builtin_nontemporal_store(o, (v4u*)(WTt + (size_t)n * ldt + 8 * c)); }
    LDS_WAIT(); asm volatile("" ::: "memory");
}
constexpr int I_FF2 = (DFF / 64) * (DM / 32), I_FF1 = (DM / 64) * (DFF / 32), I_IN = (DM / 64) * (DIN / 32), I_OUT = (DM / 64) * (DM / 32), I_G = 32 * 8;
constexpr int I_TOTAL = I_FF2 + I_FF1 + I_IN + I_OUT + I_G;
constexpr int I_DEFER = 12288, I_FF2_DEF = 4096;
constexpr int I_P0 = I_TOTAL - I_DEFER;
static_assert(I_FF1 + I_FF2_DEF == I_DEFER && I_DEFER == 256 * 6 * 8 && I_P0 == 256 * 41, "deferred weight-copy split");
constexpr int GEMV_CNT_WORD = 3600;

__device__ __forceinline__ void phase0(const Params& P, LAS unsigned char* lds) {
    const int tid = threadIdx.x, lane = tid & 63, wave = __builtin_amdgcn_readfirstlane(tid >> 6);
    const int G = gridDim.x, bx = blockIdx.x;
    unsigned char* ws = P.ws;
    {
        LAS float* s = (LAS float*)(lds + 67584);
        LAS float* red = (LAS float*)(lds + 108544);
        for (int i = tid; i < NCOND * DM; i += NTHR) { const int j = i >> 11, k = i & 2047; const float cv = (j == 0) ? P.in[4][k] : P.in[2][(j - 1) * DM + k];
            s[i] = cv * sigmoidf_(cv); }
        __syncthreads();
        for (int cb = bx; cb < 256; cb += G) {
            const int c4 = lane & 15, sub = lane >> 4, n0 = cb * 48; const bool act = c4 < 12;
            f32x4 acc[NCOND];
#pragma unroll
            for (int j = 0; j < NCOND; ++j) acc[j] = (f32x4){0.f, 0.f, 0.f, 0.f};
            const float* wp = P.in[6] + (size_t)(wave * 4 + sub) * NMOD6 + n0 + (act ? c4 : 0) * 4;
#pragma unroll 8
            for (int i = 0; i < 64; ++i) { const int r = i * 32 + wave * 4 + sub; const f32x4 wv = __builtin_nontemporal_load((const f32x4*)(wp + (size_t)i * 32 * NMOD6));
#pragma unroll
                for (int j = 0; j < NCOND; ++j) acc[j] += s[j * DM + r] * wv; }
#pragma unroll
            for (int j = 0; j < NCOND; ++j)
#pragma unroll
                for (int e = 0; e < 4; ++e) { float v = acc[j][e]; v += __shfl_xor(v, 16); v += __shfl_xor(v, 32); if (sub == 0 && act) red[(wave * NCOND + j) * 48 + c4 * 4 + e] = v; }
            __syncthreads();
            if (tid < NCOND * 48) { const int j = tid / 48, cc = tid - j * 48; float v = P.in[7][n0 + cc];
#pragma unroll
                for (int w = 0; w < 8; ++w) v += red[(w * NCOND + j) * 48 + cc];
                ((float*)(ws + WS_MOD))[j * NMOD6 + n0 + cc] = v; }
            __syncthreads();
        }
        asm volatile("s_waitcnt vmcnt(0)" ::: "memory"); __syncthreads();
        if (tid == 0) { __builtin_amdgcn_fence(__ATOMIC_RELEASE, "agent"); asm volatile("s_waitcnt vmcnt(0)" ::: "memory");
            __hip_atomic_fetch_add((unsigned*)ws + GEMV_CNT_WORD, 1u, __ATOMIC_RELAXED, __HIP_MEMORY_SCOPE_AGENT); }
    }
    LAS float* scr = (LAS float*)(lds + wave * 8448);
    const int per = (I_P0 + G - 1) / G, start = bx * per;
    for (int q = wave; q < per; q += NWAVES) {
        int r = start + q; if (r >= I_P0) break;
        if (r < I_FF2 - I_FF2_DEF) { p0_transpose_item<true>(P.in[21], DFF, DM, (bf16*)(ws + WS_WFF2), LD8, scr, r + I_FF2_DEF, lane); continue; } r -= I_FF2 - I_FF2_DEF;
        if (r < I_IN) { p0_transpose_item<false>(P.in[8], DM, DIN, (bf16*)(ws + WS_WIN), LD2, scr, r, lane); continue; } r -= I_IN;
        if (r < I_OUT) { p0_transpose_item<true>(P.in[18], DM, DM, (bf16*)(ws + WS_WOUT), LD2, scr, r, lane); continue; } r -= I_OUT;
        { const int mat = r >> 3, it = r & 7, type = mat & 1, dh = mat >> 1;
          p0_transpose_item<false>((type ? P.in[13] : P.in[11]) + (size_t)dh * 16384, 128, 128, (bf16*)(ws + WS_GWT) + (size_t)mat * 16384, 128, scr, it, lane); }
    }
}
#define TR_DEFERRED(it, b, w, Wt, WTt, Nn, Ld) do { const bool _f1 = (it) < 4; const float* _W = _f1 ? P.in[20] : P.in[21]; bf16* _WT = (bf16*)(P.ws + (_f1 ? WS_WFF1 : WS_WFF2)); \
        Nn = _f1 ? DFF : DM; Ld = _f1 ? LD2 : LD8; const int _item = (((it) - (_f1 ? 0 : 4)) * 256 + (b)) * 8 + (w); \
        const int _nblk = Nn / 32, _k0 = 64 * (_item / _nblk), _n0 = 32 * (_item % _nblk); \
        Wt = _W + (size_t)_k0 * Nn + _n0; WTt = _WT + (size_t)_n0 * Ld + _k0; } while (0)
__device__ __forceinline__ void gemv_wait(const Params& P) {
    if (threadIdx.x == 0) { unsigned* w = (unsigned*)P.ws + GEMV_CNT_WORD; unsigned sp = 0;
        while (__hip_atomic_load(w, __ATOMIC_RELAXED, __HIP_MEMORY_SCOPE_AGENT) < gridDim.x) { __builtin_amdgcn_s_sleep(2); if (++sp > (1u << 22)) break; }
        __builtin_amdgcn_fence(__ATOMIC_ACQUIRE, "agent"); asm volatile("s_waitcnt vmcnt(0)" ::: "memory"); }
    __syncthreads();
}

constexpr int HEAD_CNT_WORD = 3616;
__device__ __forceinline__ void head_publish(const Params& P) {
    asm volatile("s_waitcnt vmcnt(0)" ::: "memory"); __syncthreads();
    if (threadIdx.x == 0)
        __hip_atomic_fetch_add((unsigned*)P.ws + HEAD_CNT_WORD + 8 * (blockIdx.x & 7), 1u, __ATOMIC_RELAXED, __HIP_MEMORY_SCOPE_AGENT);
}
__device__ __forceinline__ void head_wait(const Params& P) {
    asm volatile("s_waitcnt vmcnt(0)" ::: "memory"); __syncthreads();
    if (threadIdx.x == 0) { unsigned* w = (unsigned*)P.ws + HEAD_CNT_WORD + 8 * (blockIdx.x & 7); unsigned sp = 0;
        while (__hip_atomic_load(w, __ATOMIC_RELAXED, __HIP_MEMORY_SCOPE_AGENT) < (gridDim.x >> 3)) { __builtin_amdgcn_s_sleep(2); if (++sp > (1u << 22)) break; }
        __builtin_amdgcn_fence(__ATOMIC_ACQUIRE, "agent"); asm volatile("s_waitcnt vmcnt(0)" ::: "memory"); }
    __syncthreads();
}

template <int WHICH  >
__device__ __forceinline__ void norm_mod_phase(const Params& P) {
    const int tid = threadIdx.x, lane = tid & 63, wave = __builtin_amdgcn_readfirstlane(tid >> 6);
    const int gw = blockIdx.x * NWAVES + wave, NGW = gridDim.x * NWAVES;
    const int per = (MTOK + NGW - 1) / NGW;
    const float* mod = (const float*)(P.ws + WS_MOD);
    const float* g = WHICH == 1 ? P.in[5] : P.in[19];
    const int sh_off = WHICH == 1 ? 0 : 3 * DM, sc_off = sh_off + DM;
    bf16* H = (bf16*)(P.ws + WS_H);
    int cur = -1; f32x4 cm[8], sh[8], vn[8];
    const int r0 = gw * per, r1 = ((gw + 1) * per < MTOK) ? (gw + 1) * per : MTOK;
#define NM_XROW(r) ((r) < NCTX ? P.in[0] + (size_t)(r) * DM : P.in[1] + (size_t)((r) - NCTX) * DM)
    if (r0 < r1) { const float* xr = NM_XROW(r0);
#pragma unroll
        for (int j = 0; j < 8; ++j) vn[j] = __builtin_nontemporal_load((const f32x4*)xr + lane + 64 * j); }
    for (int row = r0; row < r1; ++row) {
        const int cond = row < NCTX ? 0 : 1 + ((row - NCTX) >> 11);
        if (cond != cur) { cur = cond;
#pragma unroll
            for (int j = 0; j < 8; ++j) { const f32x4 g4 = ((const f32x4*)g)[lane + 64 * j], s4 = ((const f32x4*)(mod + cond * NMOD6 + sc_off))[lane + 64 * j];
                cm[j] = g4 * (s4 + 1.0f); sh[j] = ((const f32x4*)(mod + cond * NMOD6 + sh_off))[lane + 64 * j]; } }
        f32x4 v[8]; float ss = 0.f;
#pragma unroll
        for (int j = 0; j < 8; ++j) v[j] = vn[j];
        if (row + 1 < r1) { const float* xr = NM_XROW(row + 1);
#pragma unroll
            for (int j = 0; j < 8; ++j) vn[j] = __builtin_nontemporal_load((const f32x4*)xr + lane + 64 * j); }
        if (WHICH == 2) {
            const v2u* dr = (const v2u*)((const bf16*)(P.ws + WS_D1) + (size_t)row * DM) + lane;
#pragma unroll
            for (int j = 0; j < 8; ++j) { const v2u d = __builtin_nontemporal_load(dr + 64 * j); v[j] += (f32x4){bflo(d.x), bfhi(d.x), bflo(d.y), bfhi(d.y)}; }
            if (row >= 8192) { const v2u* pr = (const v2u*)((const bf16*)(P.ws + WS_PART) + (size_t)(row - 8192) * DM) + lane;
#pragma unroll
                for (int j = 0; j < 8; ++j) { const v2u d = __builtin_nontemporal_load(pr + 64 * j); v[j] += (f32x4){bflo(d.x), bfhi(d.x), bflo(d.y), bfhi(d.y)}; } }
            v2u* xw = (v2u*)((bf16*)(P.ws + (row < 6144 ? WS_X1A : WS_X1B)) + (size_t)(row < 6144 ? row : row - 6144) * DM) + lane;
#pragma unroll
            for (int j = 0; j < 8; ++j) { v2u w; w.x = pk2(v[j].x, v[j].y); w.y = pk2(v[j].z, v[j].w); __builtin_nontemporal_store(w, xw + 64 * j); } }
#pragma unroll
        for (int j = 0; j < 8; ++j) ss += (v[j].x * v[j].x + v[j].y * v[j].y) + (v[j].z * v[j].z + v[j].w * v[j].w);
        const float rinv = 1.0f / sqrtf(wave_sum(ss) * (1.0f / DM) + EPSN);
        v2u* o8 = (v2u*)(H + (size_t)row * LD2) + lane;
#pragma unroll
        for (int j = 0; j < 8; ++j) { const f32x4 y = v[j] * rinv * cm[j] + sh[j]; v2u w; w.x = pk2(y.x, y.y); w.y = pk2(y.z, y.w); o8[64 * j] = w; }
    }
}
__device__ __forceinline__ void final_norm_phase(const Params& P, float* dst) {
    const int tid = threadIdx.x, lane = tid & 63, wave = __builtin_amdgcn_readfirstlane(tid >> 6);
    const int gw = blockIdx.x * NWAVES + wave, NGW = gridDim.x * NWAVES;
    f32x4 g4[8];
#pragma unroll
    for (int j = 0; j < 8; ++j) g4[j] = ((const f32x4*)P.in[22])[lane + 64 * j];
    v2u vn[8];
#define FN_X1ROW(r) ((const v2u*)((const bf16*)(P.ws + ((r) < 6144 ? WS_X1A : WS_X1B)) + (size_t)((r) < 6144 ? (r) : (r) - 6144) * DM) + lane)
    if (gw < MTOK) { const v2u* xr0 = FN_X1ROW(gw);
#pragma unroll
        for (int j = 0; j < 8; ++j) vn[j] = __builtin_nontemporal_load(xr0 + 64 * j); }
    for (int row = gw; row < MTOK; row += NGW) {
        f32x4 v[8]; float ss = 0.f;
#pragma unroll
        for (int j = 0; j < 8; ++j) v[j] = (f32x4){bflo(vn[j].x), bfhi(vn[j].x), bflo(vn[j].y), bfhi(vn[j].y)};
        if (row + NGW < MTOK) { const v2u* xr1 = FN_X1ROW(row + NGW);
#pragma unroll
            for (int j = 0; j < 8; ++j) vn[j] = __builtin_nontemporal_load(xr1 + 64 * j); }
        { const v2u* dr = (const v2u*)((const bf16*)(P.ws + WS_D2) + (size_t)row * DM) + lane;
#pragma unroll
            for (int j = 0; j < 8; ++j) { const v2u d = __builtin_nontemporal_load(dr + 64 * j); v[j] += (f32x4){bflo(d.x), bfhi(d.x), bflo(d.y), bfhi(d.y)}; } }
        if (row >= 8192) { const v2u* pr = (const v2u*)((const bf16*)(P.ws + WS_PART) + (size_t)(row - 8192) * DM) + lane;
#pragma unroll
            for (int j = 0; j < 8; ++j) { const v2u d = __builtin_nontemporal_load(pr + 64 * j); v[j] += (f32x4){bflo(d.x), bfhi(d.x), bflo(d.y), bfhi(d.y)}; } }
#pragma unroll
        for (int j = 0; j < 8; ++j) ss += (v[j].x * v[j].x + v[j].y * v[j].y) + (v[j].z * v[j].z + v[j].w * v[j].w);
        const float rinv = 1.0f / sqrtf(wave_sum(ss) * (1.0f / DM) + EPSN);
        f32x4* xo = (f32x4*)(dst + (size_t)row * DM) + lane;
#pragma unroll
        for (int j = 0; j < 8; ++j) __builtin_nontemporal_store(v[j] * rinv * g4[j], xo + 64 * j);
    }
}

constexpr int XCA_P = 136;
constexpr int XCF_P = 132;
constexpr int L_XCA = 0, L_XCF = 17408, L_CW = 51200, L_HT = 53760;
static_assert(L_XCF == 64 * XCA_P * 2 && L_CW == L_XCF + 64 * XCF_P * 4 && L_HT == L_CW + 5 * 128 * 4 && L_HT + 2 * 64 * XCF_P * 4 <= 131072 && 32 * 256 * 8 <= 2 * 64 * XCF_P * 4, "rg LDS map");

template <bool REV>
__device__ __forceinline__ void scan_chunk(const LAS bf16* XCA, const LAS float* XCF, v4u* ABw, const bf16x8 (&Br)[2][4], const bf16x8 (&Bi)[2][4],
                                           const float (&bA)[2], const float (&bI)[2], const float (&sp)[2], float (&cout)[2], float (&pout)[2], int fr, int fq, int q) {
    float carry[2] = {0.f, 0.f}, ptot[2] = {1.0f, 1.0f};
#pragma unroll
    for (int mm = 0; mm < 4; ++mm) { const int m = REV ? 3 - mm : mm;
        f32x4 ar[2], ai[2];
#pragma unroll
        for (int n = 0; n < 2; ++n) { ar[n] = (f32x4){0.f, 0.f, 0.f, 0.f}; ai[n] = (f32x4){0.f, 0.f, 0.f, 0.f}; }
#pragma unroll
        for (int ks = 0; ks < 4; ++ks) { const bf16x8 a = *(const LAS bf16x8*)(XCA + (m * 16 + fr) * XCA_P + ks * 32 + fq * 8);
#pragma unroll
            for (int n = 0; n < 2; ++n) { ar[n] = __builtin_amdgcn_mfma_f32_16x16x32_bf16(a, Br[n][ks], ar[n], 0, 0, 0); ai[n] = __builtin_amdgcn_mfma_f32_16x16x32_bf16(a, Bi[n][ks], ai[n], 0, 0, 0); } }
#pragma unroll
        for (int n = 0; n < 2; ++n) {
            float la[4], bb[4];
            v4u w;
#pragma unroll
            for (int h = 0; h < 2; ++h) {
                const f32x2 kk = (f32x2){-1.442695041f, -1.442695041f}, one = (f32x2){1.0f, 1.0f};
                const f32x2 rp = (f32x2){ar[n][2 * h], ar[n][2 * h + 1]}, ip = (f32x2){ai[n][2 * h], ai[n][2 * h + 1]};
                const f32x2 tr = rp * kk + (f32x2){bA[n], bA[n]}, ti = ip * kk + (f32x2){bI[n], bI[n]};
                f32x2 er, ei; er.x = __builtin_amdgcn_exp2f(tr.x); er.y = __builtin_amdgcn_exp2f(tr.y); ei.x = __builtin_amdgcn_exp2f(ti.x); ei.y = __builtin_amdgcn_exp2f(ti.y);
                const f32x2 dr = er + one, v = ei + one;
                f32x2 rc; rc.x = __builtin_amdgcn_rcpf(dr.x); rc.y = __builtin_amdgcn_rcpf(dr.y);
                const f32x2 l2 = rc * (f32x2){sp[n], sp[n]};
                const unsigned wl = pk2(l2.x, l2.y);
                f32x2 a; a.x = __builtin_amdgcn_exp2f(bflo(wl)); a.y = __builtin_amdgcn_exp2f(bfhi(wl));
                f32x2 u = one - a * a; u.x = fmaxf(u.x, 1e-30f); u.y = fmaxf(u.y, 1e-30f);
                const f32x2 uv = u * v * v;
                f32x2 rs; rs.x = __builtin_amdgcn_rsqf(uv.x); rs.y = __builtin_amdgcn_rsqf(uv.y);
                const f32x2 xc = (f32x2){XCF[(m * 16 + fq * 4 + 2 * h) * XCF_P + q * 32 + n * 16 + fr], XCF[(m * 16 + fq * 4 + 2 * h + 1) * XCF_P + q * 32 + n * 16 + fr]};
                const f32x2 b = u * rs * xc;
                const unsigned wb = pk2(b.x, b.y);
                la[2 * h] = a.x; la[2 * h + 1] = a.y; bb[2 * h] = bflo(wb); bb[2 * h + 1] = bfhi(wb);
                if (h == 0) { w.x = wl; w.z = wb; } else { w.y = wl; w.w = wb; }
            }
            __builtin_nontemporal_store(w, ABw + (m * 2 + n) * 64);
            float Pl = 1.0f, Hl = 0.0f;
#pragma unroll
            for (int jj = 0; jj < 4; ++jj) { const int j = REV ? 3 - jj : jj; Hl = la[j] * Hl + bb[j]; Pl *= la[j]; }
#pragma unroll
            for (int kk = 0; kk < 4; ++kk) { const int k = REV ? 3 - kk : kk;
                const float Pk = __shfl(Pl, fr + 16 * k), Hk = __shfl(Hl, fr + 16 * k);
                carry[n] = Pk * carry[n] + Hk; ptot[n] *= Pk; }
        }
    }
    cout[0] = carry[0]; cout[1] = carry[1]; pout[0] = ptot[0]; pout[1] = ptot[1];
}
template <bool REV>
__device__ __forceinline__ void scan_final(const v4u (&ab)[8], LAS float* HTd, const float (&cin)[2], float (&cout)[2], int fr, int fq, int q) {
    float carry[2] = {cin[0], cin[1]};
#pragma unroll
    for (int mm = 0; mm < 4; ++mm) { const int m = REV ? 3 - mm : mm;
#pragma unroll
        for (int n = 0; n < 2; ++n) { const v4u w = ab[m * 2 + n];
            float la[4] = {bflo(w.x), bfhi(w.x), bflo(w.y), bfhi(w.y)}; const float bb[4] = {bflo(w.z), bfhi(w.z), bflo(w.w), bfhi(w.w)};
#pragma unroll
            for (int j = 0; j < 4; ++j) la[j] = __builtin_amdgcn_exp2f(la[j]);
            float Pl = 1.0f, Hl = 0.0f;
#pragma unroll
            for (int jj = 0; jj < 4; ++jj) { const int j = REV ? 3 - jj : jj; Hl = la[j] * Hl + bb[j]; Pl *= la[j]; }
            float my = 0.0f;
#pragma unroll
            for (int kk = 0; kk < 4; ++kk) { const int k = REV ? 3 - kk : kk;
                const float Pk = __shfl(Pl, fr + 16 * k), Hk = __shfl(Hl, fr + 16 * k);
                if (k == fq) my = carry[n];
                carry[n] = Pk * carry[n] + Hk; }
            float h = my;
#pragma unroll
            for (int jj = 0; jj < 4; ++jj) { const int j = REV ? 3 - jj : jj; h = la[j] * h + bb[j]; HTd[(m * 16 + fq * 4 + j) * XCF_P + q * 32 + n * 16 + fr] = h; }
        }
    }
    cout[0] = carry[0]; cout[1] = carry[1];
}

__device__ __forceinline__ void rg_phase1(const Params& P, LAS unsigned char* lds) {
    const int tid = threadIdx.x, lane = tid & 63, wave = __builtin_amdgcn_readfirstlane(tid >> 6), fr = lane & 15, fq = lane >> 4;
    const int head = blockIdx.x & 7, jb = blockIdx.x >> 3, nb = gridDim.x >> 3;
    const int dir = wave >> 2, q = wave & 3;
    unsigned char* ws = P.ws;
    const bf16* proj = (const bf16*)(ws + WS_PROJ);
    f32x2* summ = (f32x2*)(ws + WS_SUMM);
    v4u* AB = (v4u*)(ws + (dir == 0 ? WS_AB0 : WS_AB1));
    LAS bf16* XCA = (LAS bf16*)(lds + L_XCA);
    LAS float* XCF = (LAS float*)(lds + L_XCF);
    LAS float* CW = (LAS float*)(lds + L_CW);
    const bf16* gwr = (const bf16*)(ws + WS_GWT) + (size_t)((dir * 8 + head) * 2) * 16384, * gwi = gwr + 16384;
    bf16x8 Br[2][4], Bi[2][4];
#pragma unroll
    for (int n = 0; n < 2; ++n)
#pragma unroll
        for (int ks = 0; ks < 4; ++ks) { const int off = (q * 32 + n * 16 + fr) * 128 + ks * 32 + fq * 8; Br[n][ks] = *(const bf16x8*)(gwr + off); Bi[n][ks] = *(const bf16x8*)(gwi + off); }
    float bA[2], bI[2], sp[2];
#pragma unroll
    for (int n = 0; n < 2; ++n) { const int ch = dir * DRG + head * 128 + q * 32 + n * 16 + fr; bA[n] = -1.442695041f * P.in[12][ch]; bI[n] = -1.442695041f * P.in[14][ch]; sp[n] = -1.442695041f * 8.0f * log1pf(__expf(-P.in[15][ch])); }
    for (int i = tid; i < 5 * 128; i += NTHR) { const int k = i >> 7, c = i & 127; CW[i] = k < 4 ? P.in[9][k * DRG + head * 128 + c] : P.in[10][head * 128 + c]; }
    __syncthreads();
    v4u xr[4][2];
#define RG_LOAD_ITEM(cc) do { const int _row0 = (cc) * 64; int _s0, _s1; if (_row0 < NCTX) { _s0 = _row0 & ~255; _s1 = _s0 + 256; } else { _s0 = NCTX + ((_row0 - NCTX) & ~2047); _s1 = _s0 + 2048; } \
        const int _tl = tid >> 3, _c0 = (tid & 7) * 16; \
        _Pragma("unroll") for (int k = 0; k < 4; ++k) { const int r = _row0 + _tl + k - 2; xr[k][0] = (v4u){0u, 0u, 0u, 0u}; xr[k][1] = (v4u){0u, 0u, 0u, 0u}; \
            if (r >= _s0 && r < _s1) { const v4u* src = (const v4u*)(proj + (size_t)r * DIN + DRG + head * 128 + _c0); xr[k][0] = src[0]; xr[k][1] = src[1]; } } \
        } while (0)
    for (int c = jb; c < NCHUNK64; c += nb) {
        RG_LOAD_ITEM(c);
        { const int tl = tid >> 3, c0 = (tid & 7) * 16;
          float xv[16];
#pragma unroll
          for (int e4 = 0; e4 < 4; ++e4) { const f32x4 b4 = *(const LAS f32x4*)(CW + 4 * 128 + c0 + 4 * e4); xv[4 * e4] = b4.x; xv[4 * e4 + 1] = b4.y; xv[4 * e4 + 2] = b4.z; xv[4 * e4 + 3] = b4.w; }
#pragma unroll
          for (int k = 0; k < 4; ++k) { const v4u x0 = xr[k][0], x1 = xr[k][1];
              const unsigned xw[8] = {x0.x, x0.y, x0.z, x0.w, x1.x, x1.y, x1.z, x1.w};
#pragma unroll
              for (int e2 = 0; e2 < 8; ++e2) { const f32x2 w2 = *(const LAS f32x2*)(CW + k * 128 + c0 + 2 * e2); xv[2 * e2] += w2.x * bflo(xw[e2]); xv[2 * e2 + 1] += w2.y * bfhi(xw[e2]); } }
#pragma unroll
          for (int e4 = 0; e4 < 4; ++e4) *(LAS f32x4*)(XCF + tl * XCF_P + c0 + 4 * e4) = (f32x4){xv[4 * e4], xv[4 * e4 + 1], xv[4 * e4 + 2], xv[4 * e4 + 3]};
          v4u a0, a1; a0.x = pk2(xv[0], xv[1]); a0.y = pk2(xv[2], xv[3]); a0.z = pk2(xv[4], xv[5]); a0.w = pk2(xv[6], xv[7]);
          a1.x = pk2(xv[8], xv[9]); a1.y = pk2(xv[10], xv[11]); a1.z = pk2(xv[12], xv[13]); a1.w = pk2(xv[14], xv[15]);
          *(LAS v4u*)(XCA + tl * XCA_P + c0) = a0; *(LAS v4u*)(XCA + tl * XCA_P + c0 + 8) = a1; }
        const int trit = (c - jb) / nb;
        float trv[32];
        const bool tr_on = (gridDim.x == 256);
        const float* trW; bf16* trWT; int trN, trLd;
        TR_DEFERRED(trit, (int)blockIdx.x, wave, trW, trWT, trN, trLd);
        if (tr_on) tr_load(trW, trN, lane, trv);
        __syncthreads();
        float cout[2], pout[2];
        v4u* ABw = AB + ((size_t)((c * 8 + head) * 4 + q) * 8) * 64 + lane;
        if (dir == 0) scan_chunk<false>(XCA, XCF, ABw, Br, Bi, bA, bI, sp, cout, pout, fr, fq, q);
        else scan_chunk<true>(XCA, XCF, ABw, Br, Bi, bA, bI, sp, cout, pout, fr, fq, q);
        if (fq == 0) {
#pragma unroll
            for (int n = 0; n < 2; ++n)
                __hip_atomic_store((unsigned long long*)(summ + ((size_t)(dir * NCHUNK64 + c) * 8 + head) * 128 + q * 32 + n * 16 + fr),
                                   ((unsigned long long)__builtin_bit_cast(unsigned, cout[n]) << 32) | __builtin_bit_cast(unsigned, pout[n]), __ATOMIC_RELAXED, __HIP_MEMORY_SCOPE_AGENT); }
        if (tr_on) tr_store(trWT, trLd, lane, trv, (LAS float*)(lds + L_HT + wave * 8448));
        __syncthreads();
    }
    if (gridDim.x != 256) {
        LAS float* scr = (LAS float*)(lds + L_HT + wave * 8448);
        for (int d = blockIdx.x * NWAVES + wave; d < 256 * 6 * NWAVES; d += gridDim.x * NWAVES) { const int w_ = d & 7, it_ = (d >> 3) % 6, b_ = (d >> 3) / 6; const float* tw_; bf16* twt_; int tn_, tl_; TR_DEFERRED(it_, b_, w_, tw_, twt_, tn_, tl_); float wv[32]; tr_load(tw_, tn_, lane, wv); tr_store(twt_, tl_, lane, wv, scr); }
    }
#undef RG_LOAD_ITEM
}
__device__ __forceinline__ void rg_phase2(const Params& P, LAS unsigned char* lds) {
    const int tid = threadIdx.x, lane = tid & 63, wave = __builtin_amdgcn_readfirstlane(tid >> 6), fr = lane & 15, fq = lane >> 4;
    const int head = blockIdx.x & 7, jb = blockIdx.x >> 3, nb = gridDim.x >> 3;
    const int dir = wave >> 2, q = wave & 3;
    unsigned char* ws = P.ws;
    const bf16* proj = (const bf16*)(ws + WS_PROJ);
    bf16* mix = (bf16*)(ws + WS_MIX);
    const f32x2* summ = (const f32x2*)(ws + WS_SUMM);
    const v4u* AB = (const v4u*)(ws + (dir == 0 ? WS_AB0 : WS_AB1));
    LAS f32x2* CARRY = (LAS f32x2*)lds;
    LAS float* HT = (LAS float*)(lds + 63488);
    static_assert(31 * 256 * 8 == 63488 && 63488 + 2 * 64 * XCF_P * 4 <= 131072, "pass-2 LDS map");
    v4u abn[8]; f32x4 cpre[8];
#define RG_LOAD_AB(cc) do { const v4u* _s = AB + ((size_t)(((cc) * 8 + head) * 4 + q) * 8) * 64 + lane; _Pragma("unroll") for (int i = 0; i < 8; ++i) abn[i] = __builtin_nontemporal_load(_s + i * 64); } while (0)
#define RG_SEQ(cc, CS0, CS1) const int _r0 = (cc) * 64; int _q0, _q1; if (_r0 < NCTX) { _q0 = _r0 & ~255; _q1 = _q0 + 256; } else { _q0 = NCTX + ((_r0 - NCTX) & ~2047); _q1 = _q0 + 2048; } const int CS0 = _q0 >> 6, CS1 = _q1 >> 6
#define RG_LOAD_CARRY(cc) do { RG_SEQ(cc, _c0, _c1); const int _nf = (cc) - _c0, _nb = _c1 - 1 - (cc), _nst = _nf > _nb ? _nf : _nb; \
        _Pragma("unroll") for (int k = 0; k < 8; ++k) { const int idx = tid + NTHR * k; cpre[k] = (f32x4){1.f, 0.f, 1.f, 0.f}; \
            if (idx < _nst * 128) { const int i = idx >> 7, u = idx & 127, d = u >> 6, ch = (u & 63) * 2; const int c2 = d == 0 ? _c0 + i : _c1 - 1 - i; const bool valid = d == 0 ? (c2 < (cc)) : (c2 > (cc)); \
                if (valid) cpre[k] = *(const f32x4*)(summ + ((size_t)(d * NCHUNK64 + c2) * 8 + head) * 128 + ch); } } } while (0)
    if (jb < NCHUNK64) { RG_LOAD_AB(jb); RG_LOAD_CARRY(jb); }
    for (int c = jb; c < NCHUNK64; c += nb) {
        const int row0 = c * 64;
        RG_SEQ(c, cs0, cs1);
        v4u ab[8];
#pragma unroll
        for (int i = 0; i < 8; ++i) ab[i] = abn[i];
        { const int nf = c - cs0, nbk = cs1 - 1 - c, nst = nf > nbk ? nf : nbk;
#pragma unroll
          for (int k = 0; k < 8; ++k) { const int idx = tid + NTHR * k; if (idx < nst * 128) { const int i = idx >> 7, u = idx & 127; *(LAS f32x4*)(CARRY + i * 256 + (u >> 6) * 128 + (u & 63) * 2) = cpre[k]; } } }
        if (c + nb < NCHUNK64) { RG_LOAD_AB(c + nb); RG_LOAD_CARRY(c + nb); }
        v4u gyc[2];
        { const v4u* gsrc = (const v4u*)(proj + (size_t)(row0 + (tid >> 3)) * DIN + head * 128 + (tid & 7) * 16); gyc[0] = __builtin_nontemporal_load(gsrc); gyc[1] = __builtin_nontemporal_load(gsrc + 1); }
        __syncthreads();
        float cin[2] = {0.f, 0.f}, cout[2];
        if (row0 >= NCTX) { const int bl = (row0 - NCTX) >> 11;
#pragma unroll
            for (int n = 0; n < 2; ++n) cin[n] = P.in[3][(bl * 2 + dir) * DRG + head * 128 + q * 32 + n * 16 + fr]; }
        { const int my_n = dir == 0 ? c - cs0 : cs1 - 1 - c;
          for (int i = 0; i < my_n; ++i) {
#pragma unroll
              for (int n = 0; n < 2; ++n) { const f32x2 ph = CARRY[i * 256 + dir * 128 + q * 32 + n * 16 + fr]; cin[n] = ph.x * cin[n] + ph.y; } } }
        if (dir == 0) scan_final<false>(ab, HT, cin, cout, fr, fq, q); else scan_final<true>(ab, HT + 64 * XCF_P, cin, cout, fr, fq, q);
        if (row0 < NCTX && fq == 0) { const int bb = row0 >> 8, ci = c & 3;
            if ((dir == 0 && ci == 3) || (dir == 1 && ci == 0)) {
#pragma unroll
                for (int n = 0; n < 2; ++n) P.out[(size_t)MTOK * DM + (bb * 2 + dir) * DRG + head * 128 + q * 32 + n * 16 + fr] = cout[n]; } }
        __syncthreads();
        { const int tl = tid >> 3, c0 = (tid & 7) * 16;
          const v4u g0 = gyc[0], g1 = gyc[1];
          const unsigned gw_[8] = {g0.x, g0.y, g0.z, g0.w, g1.x, g1.y, g1.z, g1.w};
          unsigned ow[8];
#pragma unroll
          for (int e4 = 0; e4 < 4; ++e4) { const f32x4 hf = *(const LAS f32x4*)(HT + tl * XCF_P + c0 + 4 * e4), hb = *(const LAS f32x4*)(HT + (64 + tl) * XCF_P + c0 + 4 * e4);
              const f32x4 hs = hf + hb;
              ow[2 * e4] = pk2(pg8::gelu_tanh(bflo(gw_[2 * e4])) * hs.x, pg8::gelu_tanh(bfhi(gw_[2 * e4])) * hs.y);
              ow[2 * e4 + 1] = pk2(pg8::gelu_tanh(bflo(gw_[2 * e4 + 1])) * hs.z, pg8::gelu_tanh(bfhi(gw_[2 * e4 + 1])) * hs.w); }
          v4u* dst = (v4u*)(mix + (size_t)(row0 + tl) * LD2 + head * 128 + c0);
          dst[0] = (v4u){ow[0], ow[1], ow[2], ow[3]}; dst[1] = (v4u){ow[4], ow[5], ow[6], ow[7]}; }
    }
    __syncthreads();
#undef RG_LOAD_AB
#undef RG_LOAD_CARRY
#undef RG_SEQ
}

constexpr int VT_P = 136;
__device__ __forceinline__ void sgu_phase(const Params& P, LAS unsigned char* lds) {
    const int tid = threadIdx.x, lane = tid & 63, wave = __builtin_amdgcn_readfirstlane(tid >> 6), fr = lane & 15, fq = lane >> 4;
    const bf16* proj = (const bf16*)(P.ws + WS_PROJ);
    bf16* mix = (bf16*)(P.ws + WS_MIX);
    LAS bf16* VT = (LAS bf16*)lds;
    for (int item = blockIdx.x; item < (MTOK / 128) * 8; item += gridDim.x) {
        const int head = item & 7, chunk = item >> 3, rowb = chunk * 128;
        const int p = wave * 16 + fr;
        const size_t tok = (size_t)(rowb + p);
        f32x4 wa[4][2];
#pragma unroll
        for (int ks = 0; ks < 4; ++ks) { const f32x4* src = (const f32x4*)(P.in[16] + (size_t)(head * 128 + p) * 128 + ks * 32 + fq * 8); wa[ks][0] = src[0]; wa[ks][1] = src[1]; }
        v2u uu[8];
#pragma unroll
        for (int n = 0; n < 8; ++n) uu[n] = __builtin_nontemporal_load((const v2u*)(proj + tok * DIN + 2 * DRG + head * 128 + n * 16 + 4 * fq));
        const float bias = P.in[17][head * 128 + p];
        { const int qp = tid >> 3, dg = tid & 7, q0 = 2 * qp;
          const v4u* s0 = (const v4u*)(proj + (size_t)(rowb + q0) * DIN + 3 * DRG + head * 128 + dg * 16);
          const v4u* s1 = (const v4u*)(proj + (size_t)(rowb + q0 + 1) * DIN + 3 * DRG + head * 128 + dg * 16);
          const v4u a0 = __builtin_nontemporal_load(s0), a1 = __builtin_nontemporal_load(s0 + 1), b0 = __builtin_nontemporal_load(s1), b1 = __builtin_nontemporal_load(s1 + 1);
          const unsigned aw[8] = {a0.x, a0.y, a0.z, a0.w, a1.x, a1.y, a1.z, a1.w}, bw[8] = {b0.x, b0.y, b0.z, b0.w, b1.x, b1.y, b1.z, b1.w};
#pragma unroll
          for (int e2 = 0; e2 < 8; ++e2) {
              *(LAS unsigned*)(VT + (dg * 16 + 2 * e2) * VT_P + q0) = pk2(pg8::gelu_tanh(bflo(aw[e2])), pg8::gelu_tanh(bflo(bw[e2])));
              *(LAS unsigned*)(VT + (dg * 16 + 2 * e2 + 1) * VT_P + q0) = pk2(pg8::gelu_tanh(bfhi(aw[e2])), pg8::gelu_tanh(bfhi(bw[e2]))); } }
        __syncthreads();
        bf16x8 A[4];
#pragma unroll
        for (int ks = 0; ks < 4; ++ks) { const f32x4 w0 = wa[ks][0], w1 = wa[ks][1];
            v4u t; t.x = pk2(w0.x, w0.y); t.y = pk2(w0.z, w0.w); t.z = pk2(w1.x, w1.y); t.w = pk2(w1.z, w1.w); A[ks] = __builtin_bit_cast(bf16x8, t); }
#pragma unroll
        for (int n = 0; n < 8; ++n) { f32x4 acc = (f32x4){0.f, 0.f, 0.f, 0.f};
#pragma unroll
            for (int ks = 0; ks < 4; ++ks) { const bf16x8 b = *(const LAS bf16x8*)(VT + (n * 16 + fr) * VT_P + ks * 32 + fq * 8); acc = __builtin_amdgcn_mfma_f32_16x16x32_bf16(b, A[ks], acc, 0, 0, 0); }
            const int d0 = n * 16 + 4 * fq;
            v2u o; o.x = pk2(pg8::gelu_tanh(bflo(uu[n].x)) * (acc.x + bias), pg8::gelu_tanh(bfhi(uu[n].x)) * (acc.y + bias));
            o.y = pk2(pg8::gelu_tanh(bflo(uu[n].y)) * (acc.z + bias), pg8::gelu_tanh(bfhi(uu[n].y)) * (acc.w + bias));
            *(v2u*)(mix + tok * LD2 + DRG + head * 128 + d0) = o; }
        __syncthreads();
    }
}

#define XB_TMO      128
#define XB_XCNT(j)  (256  + 64 * (j))
#define XB_XSUB(j)  (1280 + 64 * (j))
#define XB_XGEN(j)  (2304 + 64 * (j))
#define XB_TOP      3328
#define XB_TOPGEN   3392
#define XCD_BAR_WORDS 3456
#define XB_SPIN_CAP (1u << 18)

__device__ __forceinline__ unsigned xb_ld(unsigned* p)              { return __hip_atomic_load(p, __ATOMIC_RELAXED, __HIP_MEMORY_SCOPE_AGENT); }
__device__ __forceinline__ unsigned xb_add(unsigned* p, unsigned v) { return __hip_atomic_fetch_add(p, v, __ATOMIC_RELAXED, __HIP_MEMORY_SCOPE_AGENT); }
__device__ __forceinline__ unsigned xb_xcc_id() { return (unsigned)__builtin_amdgcn_s_getreg((3 << 11) | 20) & 0xFu; }
#define XB_SPIN(cond, bar) do { unsigned _sp = 0; while (cond) { __builtin_amdgcn_s_sleep(1); \
    if ((++_sp & 255u) == 0u) { if (xb_ld(&(bar)[XB_TMO])) break; if (_sp > XB_SPIN_CAP) { atomicAdd(&(bar)[XB_TMO], 1u); break; } } } } while (0)

struct XcdBarrier {
    unsigned* bar; unsigned x;
    volatile LAS unsigned* st;
};

__device__ __forceinline__ XcdBarrier xcd_barrier_post(unsigned* bar, volatile LAS unsigned* st) {
    XcdBarrier b; b.bar = bar; b.x = xb_xcc_id(); b.st = st;
    if (threadIdx.x == 0) (void)xb_add(&bar[XB_XCNT(b.x)], 1u);
    return b;
}
__device__ __forceinline__ void xcd_barrier_complete(unsigned* bar, unsigned x, unsigned& nloc, unsigned& nx) {
    const unsigned G = gridDim.x * gridDim.y * gridDim.z;
    unsigned sum, cnt, mine, sp = 0u;
    for (;;) {
        sum = 0u; cnt = 0u; mine = 0u;
#pragma unroll
        for (unsigned j = 0; j < 16; ++j) { const unsigned c = xb_ld(&bar[XB_XCNT(j)]); sum += c; cnt += (c > 0u) ? 1u : 0u; mine = (j == x) ? c : mine; }
        if (sum == G) break;
        __builtin_amdgcn_s_sleep(1);
        if ((++sp & 255u) == 0u) { if (xb_ld(&bar[XB_TMO])) break; if (sp > XB_SPIN_CAP) { atomicAdd(&bar[XB_TMO], 1u); break; } }
    }
    nloc = mine > 0u ? mine : 1u; nx = cnt > 0u ? cnt : 1u;
}

__device__ __forceinline__ void xcd_barrier(const XcdBarrier& b) {
    asm volatile("s_waitcnt vmcnt(0)" ::: "memory");
    __syncthreads();
    if (threadIdx.x == 0) {
        unsigned* bar = b.bar;
        __builtin_amdgcn_s_waitcnt(0);
        unsigned nloc = b.st[0], nx = b.st[1];
        if (nloc == 0u) { xcd_barrier_complete(bar, b.x, nloc, nx); b.st[0] = nloc; b.st[1] = nx; }
        const unsigned old = xb_add(&bar[XB_XSUB(b.x)], 1u);
        const unsigned gen = old / nloc;
        if (old + 1u == (gen + 1u) * nloc) {
            __builtin_amdgcn_fence(__ATOMIC_RELEASE, "agent");
            asm volatile("s_waitcnt vmcnt(0)" ::: "memory");
            const unsigned og = xb_add(&bar[XB_TOP], 1u);
            const unsigned tg = og / nx;
            if (og + 1u == (tg + 1u) * nx) xb_add(&bar[XB_TOPGEN], 1u);
            else XB_SPIN(xb_ld(&bar[XB_TOPGEN]) == tg, bar);
            __builtin_amdgcn_fence(__ATOMIC_ACQUIRE, "agent");
            xb_add(&bar[XB_XGEN(b.x)], 1u);
            asm volatile("s_waitcnt vmcnt(0)" ::: "memory");
        } else {
            XB_SPIN(xb_ld(&bar[XB_XGEN(b.x)]) == gen, bar);
            __builtin_amdgcn_fence(__ATOMIC_ACQUIRE, "agent");
            asm volatile("s_waitcnt vmcnt(0)" ::: "memory");
        }
    }
    __syncthreads();
}

constexpr int N_PHASES = 10;
__global__ void __launch_bounds__(NTHR, 2) mk_fwd(Params P) {
    extern __shared__ __attribute__((aligned(16))) unsigned char lds_raw[];
    LAS unsigned char* lds = (LAS unsigned char*)lds_raw;
    cg::grid_group grid = cg::this_grid();
    const int lo = P.ph_lo, hi = P.ph_hi, G = gridDim.x;
    unsigned char* ws = P.ws;
#define IN(k) (lo <= (k) && (k) < hi)
    volatile LAS unsigned* bst = (volatile LAS unsigned*)(lds + 131072 + 64);
    if (threadIdx.x < 2) bst[threadIdx.x] = 0u;
    __syncthreads();
    XcdBarrier xbar; xbar.bar = (unsigned*)ws; xbar.x = 0; xbar.st = bst;
    if (hi - lo > 1) xbar = xcd_barrier_post((unsigned*)ws, bst);
    if (lo < 0) grid.sync();
#define SEAM(k) do { if (IN(k) && IN((k) + 1)) xcd_barrier(xbar); } while (0)
    if (IN(0)) { phase0(P, lds); __syncthreads(); }
    if (IN(0) && IN(1)) gemv_wait(P);
    if (IN(1)) norm_mod_phase<1>(P);
    SEAM(1);
    if (IN(2)) { pg8::Gemm g{(const bf16*)(ws + WS_H), (const bf16*)(ws + WS_WIN), MTOK, DIN, DM, LD2}; pg8::StaticOrder S; S.init(MTOK, DIN, DM, G, (int)blockIdx.x);
        pg8::EpiProj E{(bf16*)(ws + WS_PROJ), DIN};
        pg8::gemm_phase<pg8::EpiProj, pg8::StaticOrder, true, true>(lds, g, S, E); }
    SEAM(2);
    if (IN(3)) { rg_phase1(P, lds); if (IN(4)) head_publish(P); sgu_phase(P, lds); }
    if (IN(3) && IN(4)) head_wait(P);
    if (IN(4)) rg_phase2(P, lds);
    SEAM(4);
    if (IN(5)) { pg8::Gemm g{(const bf16*)(ws + WS_MIX), (const bf16*)(ws + WS_WOUT), MTOK, DM, DM, LD2}; pg8::SplitOrder S; S.init(DM, G, (int)blockIdx.x);
        pg8::EpiDelta E{(bf16*)(ws + WS_D1), (bf16*)(ws + WS_PART), (const float*)(ws + WS_MOD) + 2 * DM};
        pg8::gemm_phase<pg8::EpiDelta, pg8::SplitOrder, true, true>(lds, g, S, E); }
    SEAM(5);
    if (IN(6)) norm_mod_phase<2>(P);
    SEAM(6);
    if (IN(7)) { pg8::Gemm g{(const bf16*)(ws + WS_H), (const bf16*)(ws + WS_WFF1), MTOK, DFF, DM, LD2}; pg8::StaticOrder S; S.init(MTOK, DFF, DM, G, (int)blockIdx.x);
        pg8::EpiRelu2 E{(bf16*)(ws + WS_F), LD8};
        pg8::gemm_phase<pg8::EpiRelu2, pg8::StaticOrder, false, true>(lds, g, S, E); }
    SEAM(7);
    if (IN(8)) { pg8::Gemm g{(const bf16*)(ws + WS_F), (const bf16*)(ws + WS_WFF2), MTOK, DM, DFF, LD8}; pg8::SplitOrder S; S.init(DFF, G, (int)blockIdx.x);
        pg8::EpiDelta E{(bf16*)(ws + WS_D2), (bf16*)(ws + WS_PART), (const float*)(ws + WS_MOD) + 5 * DM};
        pg8::gemm_phase<pg8::EpiDelta, pg8::SplitOrder, true, true>(lds, g, S, E); }
    SEAM(8);
    if (IN(9)) final_norm_phase(P, P.out);
#undef IN
#undef SEAM
}

extern "C" void kernel_launch(void* const* d_in, const int* in_sizes, int n_in, void* d_out, int out_size, void* d_ws, size_t ws_size, hipStream_t stream) {
    static int grid = 0;
    if (grid == 0) {
        if (n_in != 23 || ws_size < WS_END) { fprintf(stderr, "kernel_launch: unexpected n_in %d / ws_size %zu\n", n_in, ws_size); grid = -1; return; }
        int dev = 0, cus = 0, per_cu = 0;
        (void)hipGetDevice(&dev); (void)hipDeviceGetAttribute(&cus, hipDeviceAttributeMultiprocessorCount, dev);
        if (hipFuncSetAttribute((const void*)mk_fwd, hipFuncAttributeMaxDynamicSharedMemorySize, LDS_BYTES) != hipSuccess) { fprintf(stderr, "kernel_launch: hipFuncSetAttribute failed\n"); grid = -1; return; }
        if (hipOccupancyMaxActiveBlocksPerMultiprocessor(&per_cu, (const void*)mk_fwd, NTHR, LDS_BYTES) != hipSuccess || per_cu < 1) fprintf(stderr, "kernel_launch: occupancy query says %d\n", per_cu);
        (void)hipGetLastError();
        grid = cus > 0 ? cus : 256;
        if (grid > 256) grid = 256;
        grid &= ~7;
    }
    if (grid < 0) return;
    Params p{};
    for (int i = 0; i < 23; ++i) p.in[i] = (const float*)d_in[i];
    p.out = (float*)d_out; p.ws = (unsigned char*)d_ws;
    p.ph_lo = 0; p.ph_hi = N_PHASES;
    if (hipMemsetAsync(d_ws, 0, 16384, stream) != hipSuccess) { fprintf(stderr, "kernel_launch: memset of the barrier words failed\n"); return; }
    void* args[] = {&p};
    hipError_t e = hipLaunchCooperativeKernel((const void*)mk_fwd, dim3(grid), dim3(NTHR), args, LDS_BYTES, stream);
    if (e != hipSuccess) fprintf(stderr, "cooperative launch failed: %s (grid %d)\n", hipGetErrorString(e), grid);
}
```

```cpp
#include <hip/hip_runtime.h>
#include <hip/hip_cooperative_groups.h>
#include <cstdio>
#include <cstdint>
namespace cg = cooperative_groups;
namespace pg8 {
#define PG8_LAS __attribute__((address_space(3)))
typedef unsigned short bf16_t;
typedef short bf16x8 __attribute__((ext_vector_type(8)));
typedef float f32x4 __attribute__((ext_vector_type(4)));
typedef unsigned u32x4 __attribute__((ext_vector_type(4)));
constexpr int BM = 256, BK = 64, HALF = 128, HTB = HALF * BK * 2  , STAGE_BYTES = 8 * HTB, NXCD = 8, WGM = 8;

__host__ __device__ __forceinline__ int lds_byte(int r, int c) { const int st = (r >> 4) * 2 + (c >> 5), rr = r & 15, cc = c & 31, ob = rr * 64 + cc * 2; return st * 1024 + (ob ^ (((ob >> 9) & 1) << 5)); }
__host__ __device__ __forceinline__ void stage_rc(int b, int& R, int& C) { const int st = b / 1024, sb = b % 1024, swz = sb ^ (((sb >> 9) & 1) << 5); R = (st >> 1) * 16 + swz / 64; C = (st & 1) * 32 + (swz % 64) / 2; }
__host__ __device__ __forceinline__ int perm32(int rho) { const int n = rho >> 4, i = rho & 15; return 8 * (i >> 2) + 4 * n + (i & 3); }

struct Unit { int pm, pn, k0, nt, part; };
struct Gemm { const bf16_t* A; const bf16_t* Bt; int M, N, K, ld; };

struct StaticOrder {
    int nM, nN, nwg, G, c, ntk;
    __host__ __device__ void init(int M, int N, int K, int G_, int c_) { nM = M / BM; nN = N / BM; nwg = nM * nN; G = G_; c = c_; ntk = K / BK; }
    __host__ __device__ bool next(int i, Unit& u) const {
        const long L = (long)i * G + c; if (L >= nwg) return false;
        int wgid = (int)L; { const int q = nwg / NXCD, r = nwg % NXCD, xcd = wgid % NXCD, off = wgid / NXCD; wgid = (xcd < r ? xcd * (q + 1) : r * (q + 1) + (xcd - r) * q) + off; }
        const int nig = WGM * nN, gid = wgid / nig, fm = gid * WGM, gsz = (nM - fm) < WGM ? (nM - fm) : WGM;
        u.pm = fm + ((wgid % nig) % gsz); u.pn = (wgid % nig) / gsz; u.k0 = 0; u.nt = ntk; u.part = 0; return true;
    }
    __device__ __forceinline__ void a_ready(const Unit&) const {}
    __device__ __forceinline__ void done(const Unit&) const {}
};
__device__ __forceinline__ unsigned cvt_pk_bf16(float lo, float hi) { unsigned r; asm volatile("v_cvt_pk_bf16_f32 %0, %1, %2" : "=v"(r) : "v"(lo), "v"(hi)); return r; }
__device__ __forceinline__ float gelu_tanh(float x) {
    const float u = x * (0.7978845608f + 0.0356774081f * x * x);
    const float e = __builtin_amdgcn_exp2f(-2.885390082f * u);
    return x * __builtin_amdgcn_rcpf(1.0f + e);
}
struct EpiProj {
    static constexpr bool PERM = true, AFTER_DRAIN = false;
    bf16_t* O; int ldc;
    __device__ __forceinline__ void operator()(const f32x4 (&acc)[2][2][4][2], const Unit& u, int wr, int wc, int fr, int fq) const {
        const int row0 = u.pm * BM + wr * 64 + fr, col0 = u.pn * BM + wc * 32 + 8 * fq;
#pragma unroll
        for (int ai = 0; ai < 2; ++ai)
#pragma unroll
            for (int m = 0; m < 4; ++m) { bf16_t* rowp = O + (size_t)(row0 + ai * HALF + m * 16) * ldc + col0;
#pragma unroll
                for (int bj = 0; bj < 2; ++bj) { const f32x4 v0 = acc[ai][bj][m][0], v1 = acc[ai][bj][m][1];
                    u32x4 w; w.x = cvt_pk_bf16(v0[0], v0[1]); w.y = cvt_pk_bf16(v0[2], v0[3]); w.z = cvt_pk_bf16(v1[0], v1[1]); w.w = cvt_pk_bf16(v1[2], v1[3]);
                    *(u32x4*)(rowp + bj * HALF) = w; } }
    }
};
struct EpiRelu2 {
    static constexpr bool PERM = true, AFTER_DRAIN = false;
    bf16_t* O; int ldc;
    __device__ __forceinline__ void operator()(const f32x4 (&acc)[2][2][4][2], const Unit& u, int wr, int wc, int fr, int fq) const {
        const int row0 = u.pm * BM + wr * 64 + fr, col0 = u.pn * BM + wc * 32 + 8 * fq;
#pragma unroll
        for (int ai = 0; ai < 2; ++ai)
#pragma unroll
            for (int m = 0; m < 4; ++m) { bf16_t* rowp = O + (size_t)(row0 + ai * HALF + m * 16) * ldc + col0;
#pragma unroll
                for (int bj = 0; bj < 2; ++bj) { f32x4 v0 = acc[ai][bj][m][0], v1 = acc[ai][bj][m][1];
#pragma unroll
                    for (int j = 0; j < 4; ++j) { const float a = fmaxf(v0[j], 0.f), b = fmaxf(v1[j], 0.f); v0[j] = a * a; v1[j] = b * b; }
                    u32x4 w; w.x = cvt_pk_bf16(v0[0], v0[1]); w.y = cvt_pk_bf16(v0[2], v0[3]); w.z = cvt_pk_bf16(v1[0], v1[1]); w.w = cvt_pk_bf16(v1[2], v1[3]);
                    __builtin_nontemporal_store(w, (u32x4*)(rowp + bj * HALF)); } }
    }
};
struct SplitOrder {
    int G, c, ntk;
    __host__ __device__ void init(int K, int G_, int c_) { G = G_; c = c_; ntk = K / BK; }
    __host__ __device__ bool next(int i, Unit& u) const {
        const long L = (long)i * G + c; if (L >= 512) return false;
        if (L < 256) { const int xcd = (int)L & 7, off = (int)L >> 3;
            u.pm = xcd * 4 + (off & 3); u.pn = off >> 2; u.k0 = 0; u.nt = ntk; u.part = 0; return true; }
        const int hl = (int)L - 256, x = hl & 7, off = hl >> 3, pr = x >> 1, kh = x & 1;
        u.pm = 32 + pr * 4 + (off & 3); u.pn = off >> 2; u.k0 = kh * (ntk / 2) * BK; u.nt = ntk / 2; u.part = kh; return true;
    }
    __device__ __forceinline__ void a_ready(const Unit&) const {}
    __device__ __forceinline__ void done(const Unit&) const {}
};
struct EpiRes {
    static constexpr bool PERM = false, AFTER_DRAIN = false;
    const float* base0; const float* base1; float* out; const float* gate; float* part;
    __device__ __forceinline__ void operator()(const f32x4 (&acc)[2][2][4][2], const Unit& u, int wr, int wc, int fr, int fq) const {
        const int row0 = u.pm * BM + wr * 64 + fr, col0 = u.pn * BM + wc * 32 + 4 * fq;
        const int cond = u.pm < 16 ? 0 : 1 + ((u.pm - 16) >> 3);
        const float* gp = gate + cond * 12288 + col0;
        const float* bb = u.pm < 16 ? base0 + (size_t)row0 * 2048 + col0 : base1 + (size_t)(row0 - 4096) * 2048 + col0;
        float* ob = out + (size_t)row0 * 2048 + col0;
        float* pb = part + ((size_t)row0 - 8192) * 2048 + col0;
        f32x4 gv[2][2];
#pragma unroll
        for (int bj = 0; bj < 2; ++bj)
#pragma unroll
            for (int n = 0; n < 2; ++n) gv[bj][n] = *(const f32x4*)(gp + bj * HALF + n * 16);
#pragma unroll
        for (int ai = 0; ai < 2; ++ai)
#pragma unroll
            for (int m = 0; m < 4; ++m) { const size_t ro = (size_t)(ai * HALF + m * 16) * 2048;
#pragma unroll
                for (int bj = 0; bj < 2; ++bj)
#pragma unroll
                    for (int n = 0; n < 2; ++n) {
                        if (u.part) *(f32x4*)(pb + ro + bj * HALF + n * 16) = gv[bj][n] * acc[ai][bj][m][n];
                        else { const f32x4 b = *(const f32x4*)(bb + ro + bj * HALF + n * 16); *(f32x4*)(ob + ro + bj * HALF + n * 16) = b + gv[bj][n] * acc[ai][bj][m][n]; } }
                asm volatile("" ::: "memory"); }
    }
};
struct EpiDelta {
    static constexpr bool PERM = true, AFTER_DRAIN = false;
    bf16_t* D; bf16_t* Dpart; const float* gate;
    __device__ __forceinline__ void operator()(const f32x4 (&acc)[2][2][4][2], const Unit& u, int wr, int wc, int fr, int fq) const {
        const int row0 = u.pm * BM + wr * 64 + fr, col0 = u.pn * BM + wc * 32 + 8 * fq;
        const int cond = u.pm < 16 ? 0 : 1 + ((u.pm - 16) >> 3);
        const float* gp = gate + cond * 12288 + col0;
        f32x4 g0[2], g1[2];
#pragma unroll
        for (int bj = 0; bj < 2; ++bj) { g0[bj] = *(const f32x4*)(gp + bj * HALF); g1[bj] = *(const f32x4*)(gp + bj * HALF + 4); }
        bf16_t* base = (u.part ? Dpart + ((long)row0 - 8192) * 2048 : D + (long)row0 * 2048) + col0;
#pragma unroll
        for (int ai = 0; ai < 2; ++ai)
#pragma unroll
            for (int m = 0; m < 4; ++m) { bf16_t* rowp = base + (long)(ai * HALF + m * 16) * 2048;
#pragma unroll
                for (int bj = 0; bj < 2; ++bj) { const f32x4 v0 = acc[ai][bj][m][0] * g0[bj], v1 = acc[ai][bj][m][1] * g1[bj];
                    u32x4 w; w.x = cvt_pk_bf16(v0[0], v0[1]); w.y = cvt_pk_bf16(v0[2], v0[3]); w.z = cvt_pk_bf16(v1[0], v1[1]); w.w = cvt_pk_bf16(v1[2], v1[3]);
                    *(u32x4*)(rowp + bj * HALF) = w; } }
    }
};
template <class Epi, class Sched, bool ALIGN_EPI = false, bool SP2 = false>
__device__ __forceinline__ void gemm_phase(PG8_LAS unsigned char* lds, const Gemm g, const Sched& S, const Epi& E) {
    const int tid = threadIdx.x, wid = __builtin_amdgcn_readfirstlane(tid >> 6), lane = tid & 63, wr = wid >> 2, wc = wid & 3, fr = lane & 15, fq = lane >> 4;
    const int K = g.ld;
    unsigned voffA[2], voffB[2];
#pragma unroll
    for (int i = 0; i < 2; ++i) { int R, C; stage_rc(tid * 16 + i * 8192, R, C); const int Rb = Epi::PERM ? ((R & ~31) + perm32(R & 31)) : R;
        voffA[i] = (unsigned)(R * K + C) * 2u; voffB[i] = (unsigned)(Rb * K + C) * 2u; }
    const size_t kstep = (size_t)(BK * 2);
    const size_t hstep = (size_t)HALF * K * 2;
    const size_t tstep = 2 * hstep;
    const unsigned ldsw = (unsigned)wid * 1024u;
    const int aoff = lds_byte(wr * 64 + fr, fq * 8), boff = lds_byte(wc * 32 + fr, fq * 8);
#define PG8_SA(b, h) (((b) * 2 + (h)) * HTB)
#define PG8_SB(b, h) ((4 + (b) * 2 + (h)) * HTB)
#define PG8_STAGE(bufoff, gbase, voff) do { _Pragma("unroll") for (int _i = 0; _i < 2; ++_i) \
        __builtin_amdgcn_global_load_lds((const unsigned*)((const char*)(gbase) + (voff)[_i]), (PG8_LAS unsigned*)(lds + (bufoff) + ldsw + _i * 8192), 16, 0, 0); } while (0)
#define PG8_LDA(dst, b, h) do { _Pragma("unroll") for (int m = 0; m < 4; ++m) _Pragma("unroll") for (int k = 0; k < 2; ++k) dst[m][k] = *(const PG8_LAS bf16x8*)(lds + PG8_SA(b, h) + aoff + m * 2048 + k * 1024); } while (0)
#define PG8_LDB(dst, b, h) do { _Pragma("unroll") for (int n = 0; n < 2; ++n) _Pragma("unroll") for (int k = 0; k < 2; ++k) dst[n][k] = *(const PG8_LAS bf16x8*)(lds + PG8_SB(b, h) + boff + n * 2048 + k * 1024); } while (0)
#define PG8_MMA(ai, bj, At, Bt) do { __builtin_amdgcn_s_setprio(1); _Pragma("unroll") for (int m = 0; m < 4; ++m) _Pragma("unroll") for (int n = 0; n < 2; ++n) _Pragma("unroll") for (int k = 0; k < 2; ++k) \
        acc[ai][bj][m][n] = __builtin_amdgcn_mfma_f32_16x16x32_bf16(Bt[n][k], At[m][k], acc[ai][bj][m][n], 0, 0, 0); __builtin_amdgcn_s_setprio(0); } while (0)
#define PG8_WAIT_V(n) asm volatile("s_waitcnt vmcnt(" #n ")" ::: "memory")
#define PG8_WAIT_L(n) asm volatile("s_waitcnt lgkmcnt(" #n ")" ::: "memory")
#define PG8_BAR __builtin_amdgcn_s_barrier()
#define PG8_SCHED __builtin_amdgcn_sched_barrier(0)
    Unit cur, nxt; int ui = 0;
    if (!S.next(0, cur)) return;
    f32x4 acc[2][2][4][2];
#pragma unroll
    for (int a = 0; a < 2; ++a)
#pragma unroll
        for (int b = 0; b < 2; ++b)
#pragma unroll
            for (int m = 0; m < 4; ++m)
#pragma unroll
                for (int n = 0; n < 2; ++n) acc[a][b][m][n] = (f32x4){0.f, 0.f, 0.f, 0.f};
    bf16x8 At[4][2], B0[2][2], B1[2][2];
    const char* cA = (const char*)g.A + (size_t)cur.pm * tstep + (size_t)cur.k0 * 2; const char* cB = (const char*)g.Bt + (size_t)cur.pn * tstep + (size_t)cur.k0 * 2;
    S.a_ready(cur);
    if constexpr (SP2) {
        PG8_STAGE(PG8_SB(0, 0), cB, voffB); PG8_STAGE(PG8_SB(0, 1), cB + hstep, voffB); PG8_STAGE(PG8_SA(0, 0), cA, voffA); PG8_STAGE(PG8_SA(0, 1), cA + hstep, voffA);
        if (wr == 1) PG8_BAR;
        PG8_WAIT_V(2); PG8_BAR;
        PG8_STAGE(PG8_SB(1, 0), cB + kstep, voffB); PG8_STAGE(PG8_SA(1, 0), cA + kstep, voffA); PG8_STAGE(PG8_SB(1, 1), cB + hstep + kstep, voffB);
        PG8_WAIT_V(6); PG8_BAR;
    } else {
        PG8_STAGE(PG8_SB(0, 0), cB, voffB); PG8_STAGE(PG8_SA(0, 0), cA, voffA); PG8_STAGE(PG8_SB(0, 1), cB + hstep, voffB); PG8_STAGE(PG8_SA(0, 1), cA + hstep, voffA);
        if (wr == 1) PG8_BAR;
        PG8_WAIT_V(4); PG8_BAR;
        PG8_STAGE(PG8_SB(1, 0), cB + kstep, voffB); PG8_STAGE(PG8_SA(1, 0), cA + kstep, voffA); PG8_STAGE(PG8_SB(1, 1), cB + hstep + kstep, voffB);
        PG8_WAIT_V(6); PG8_BAR;
    }
    for (;;) {
        const bool has_next = S.next(ui + 1, nxt);
        const char* nA = has_next ? (const char*)g.A + (size_t)nxt.pm * tstep + (size_t)nxt.k0 * 2 : cA; const char* nB = has_next ? (const char*)g.Bt + (size_t)nxt.pn * tstep + (size_t)nxt.k0 * 2 : cB;
        const int nt = cur.nt;
        for (int t = 0; t < nt; t += 2) {
            const bool last = (t == nt - 2);
            const char* a1 = cA + (size_t)(t + 1) * kstep;
            const char* a2 = last ? nA : cA + (size_t)(t + 2) * kstep; const char* b2 = last ? nB : cB + (size_t)(t + 2) * kstep;
            const char* a3 = a2 + kstep; const char* b3 = b2 + kstep;
            if (last && has_next) S.a_ready(nxt);
            if constexpr (SP2) {
            PG8_LDB(B0, 0, 0); PG8_LDB(B1, 0, 1); PG8_SCHED; PG8_LDA(At, 0, 0); PG8_STAGE(PG8_SA(1, 1), a1 + hstep, voffA);
            PG8_WAIT_V(8); PG8_WAIT_L(0); PG8_BAR; PG8_MMA(0, 0, At, B0); PG8_MMA(0, 1, At, B1); PG8_BAR; PG8_SCHED;
            PG8_LDA(At, 0, 1); PG8_STAGE(PG8_SB(0, 0), b2, voffB); PG8_STAGE(PG8_SB(0, 1), b2 + hstep, voffB); PG8_STAGE(PG8_SA(0, 0), a2, voffA);
            PG8_WAIT_V(8); PG8_WAIT_L(0); PG8_BAR; PG8_MMA(1, 0, At, B0); PG8_MMA(1, 1, At, B1); PG8_BAR; PG8_SCHED;
            PG8_LDB(B0, 1, 0); PG8_LDB(B1, 1, 1); PG8_SCHED; PG8_LDA(At, 1, 0); PG8_STAGE(PG8_SA(0, 1), a2 + hstep, voffA);
            PG8_WAIT_V(8); PG8_WAIT_L(0); PG8_BAR; PG8_MMA(0, 0, At, B0); PG8_MMA(0, 1, At, B1); PG8_BAR; PG8_SCHED;
            PG8_LDA(At, 1, 1); PG8_STAGE(PG8_SB(1, 0), b3, voffB); PG8_STAGE(PG8_SB(1, 1), b3 + hstep, voffB); PG8_STAGE(PG8_SA(1, 0), a3, voffA);
            PG8_WAIT_V(8); PG8_WAIT_L(0); PG8_BAR; PG8_MMA(1, 0, At, B0); PG8_MMA(1, 1, At, B1); PG8_BAR; PG8_SCHED;
            } else {
            PG8_LDB(B0, 0, 0); PG8_SCHED; PG8_LDA(At, 0, 0); PG8_STAGE(PG8_SA(1, 1), a1 + hstep, voffA);
            PG8_WAIT_L(8); PG8_BAR; PG8_WAIT_L(0); PG8_MMA(0, 0, At, B0); PG8_BAR; PG8_SCHED;
            PG8_LDB(B1, 0, 1); PG8_STAGE(PG8_SB(0, 0), b2, voffB);
            PG8_BAR; PG8_WAIT_L(0); PG8_MMA(0, 1, At, B1); PG8_BAR;
            PG8_LDA(At, 0, 1); PG8_STAGE(PG8_SA(0, 0), a2, voffA);
            PG8_BAR; PG8_WAIT_L(0); PG8_MMA(1, 0, At, B0); PG8_BAR; PG8_SCHED;
            PG8_STAGE(PG8_SB(0, 1), b2 + hstep, voffB);
            PG8_WAIT_V(6); PG8_BAR; PG8_MMA(1, 1, At, B1); PG8_BAR;
            PG8_LDB(B0, 1, 0); PG8_SCHED; PG8_LDA(At, 1, 0); PG8_STAGE(PG8_SA(0, 1), a2 + hstep, voffA);
            PG8_WAIT_L(8); PG8_BAR; PG8_WAIT_L(0); PG8_MMA(0, 0, At, B0); PG8_BAR; PG8_SCHED;
            PG8_LDB(B1, 1, 1); PG8_STAGE(PG8_SB(1, 0), b3, voffB);
            PG8_BAR; PG8_WAIT_L(0); PG8_MMA(0, 1, At, B1); PG8_BAR;
            PG8_LDA(At, 1, 1); PG8_STAGE(PG8_SA(1, 0), a3, voffA);
            PG8_BAR; PG8_WAIT_L(0); PG8_MMA(1, 0, At, B0); PG8_BAR; PG8_SCHED;
            PG8_STAGE(PG8_SB(1, 1), b3 + hstep, voffB);
            PG8_WAIT_V(6); PG8_BAR; PG8_MMA(1, 1, At, B1); PG8_BAR;
            }
        }
        if constexpr (ALIGN_EPI) { if (wr == 0) PG8_BAR; }
        if constexpr (!Epi::AFTER_DRAIN) { E(acc, cur, wr, wc, fr, fq); S.done(cur); }
        if (!has_next) break;
#pragma unroll
        for (int a = 0; a < 2; ++a)
#pragma unroll
            for (int b = 0; b < 2; ++b)
#pragma unroll
                for (int m = 0; m < 4; ++m)
#pragma unroll
                    for (int n = 0; n < 2; ++n) acc[a][b][m][n] = (f32x4){0.f, 0.f, 0.f, 0.f};
        cur = nxt; cA = nA; cB = nB; ++ui;
        if constexpr (ALIGN_EPI) { if (wr == 1) PG8_BAR; }
    }
    PG8_WAIT_V(0);
    if constexpr (!ALIGN_EPI) { if (wr == 0) PG8_BAR; }
    PG8_BAR;
    if constexpr (Epi::AFTER_DRAIN) { E.fused(acc, cur, wr, wc, fr, fq, lds, wid, lane); S.done(cur); }
#undef PG8_SA
#undef PG8_SB
#undef PG8_STAGE
#undef PG8_LDA
#undef PG8_LDB
#undef PG8_MMA
#undef PG8_WAIT_V
#undef PG8_WAIT_L
#undef PG8_BAR
#undef PG8_SCHED
}
}

constexpr int DM = 2048, NCTX = 4096, NLAT = 8192, MTOK = NCTX + NLAT, DRG = 1024, DIN = 4096, DFF = 8192, NMOD6 = 12288, NCOND = 5;
constexpr int NCHUNK64 = MTOK / 64;
constexpr float EPSN = 1e-6f;
constexpr size_t MiB = 1u << 20;
constexpr size_t WS_MOD = 1 * MiB;
constexpr size_t WS_GWT = 2 * MiB;
constexpr size_t WS_SUMM = 4 * MiB;
constexpr int LD2 = DM + 64, LD8 = DFF + 64;
constexpr size_t WS_WFF2 = 8 * MiB;
constexpr size_t WS_WIN = 41 * MiB;
constexpr size_t WS_WOUT = 58 * MiB;
constexpr size_t WS_WFF1 = 67 * MiB;
constexpr size_t WS_H = 100 * MiB;
constexpr size_t WS_PROJ = 150 * MiB;
constexpr size_t WS_MIX = 246 * MiB;
constexpr size_t WS_F = 150 * MiB;
constexpr size_t WS_PART = 344 * MiB;
constexpr size_t WS_D1 = WS_PROJ;
constexpr size_t WS_AB0 = WS_H;
constexpr size_t WS_AB1 = 296 * MiB;
constexpr size_t WS_D2 = WS_H;
constexpr size_t WS_X1A = 41 * MiB;
constexpr size_t WS_X1B = 360 * MiB;
constexpr size_t WS_END = 384 * MiB;
static_assert(WS_WFF2 + (size_t)DM * LD8 * 2 <= WS_WIN && WS_WIN + (size_t)DIN * LD2 * 2 <= WS_WOUT && WS_WOUT + (size_t)DM * LD2 * 2 <= WS_WFF1 && WS_WFF1 + (size_t)DFF * LD2 * 2 <= WS_H &&
              WS_H + (size_t)MTOK * LD2 * 2 <= WS_PROJ && WS_PROJ + (size_t)MTOK * DIN * 2 <= WS_MIX && WS_MIX + (size_t)MTOK * LD2 * 2 <= WS_PART && WS_F + (size_t)MTOK * LD8 * 2 <= WS_PART &&
              WS_MIX + (size_t)MTOK * LD2 * 2 <= WS_AB1 && WS_AB1 + (size_t)NCHUNK64 * 8 * 4 * 8 * 64 * 16 <= WS_PART && (size_t)NCHUNK64 * 8 * 4 * 8 * 64 * 16 <= (size_t)MTOK * LD2 * 2, "d_ws map");
static_assert(WS_X1A + (size_t)6144 * DM * 2 <= WS_WFF1 && WS_PART + (size_t)4096 * DM * 2 <= WS_X1B && WS_X1B + (size_t)6144 * DM * 2 <= WS_END, "x1 halves");
constexpr int LDS_BYTES = 147456;
constexpr int NWAVES = 8, NTHR = 512;

#define GAS __attribute__((address_space(1)))
#define LAS __attribute__((address_space(3)))
typedef unsigned short bf16;
typedef unsigned v4u __attribute__((ext_vector_type(4)));
typedef unsigned v2u __attribute__((ext_vector_type(2)));
typedef float f32x4 __attribute__((ext_vector_type(4)));
typedef float f32x2 __attribute__((ext_vector_type(2)));
typedef short bf16x8 __attribute__((ext_vector_type(8)));
#define LDS_WAIT() asm volatile("s_waitcnt lgkmcnt(0)" ::: "memory")
__device__ __forceinline__ unsigned pk2(float lo, float hi) { return pg8::cvt_pk_bf16(lo, hi); }
__device__ __forceinline__ float bflo(unsigned u) { return __builtin_bit_cast(float, u << 16); }
__device__ __forceinline__ float bfhi(unsigned u) { return __builtin_bit_cast(float, u & 0xffff0000u); }
__device__ __forceinline__ float wave_sum(float v) {
#pragma unroll
    for (int o = 1; o < 64; o <<= 1) v += __shfl_xor(v, o);
    return v;
}
__device__ __forceinline__ float sigmoidf_(float x) { return __builtin_amdgcn_rcpf(1.0f + __builtin_amdgcn_exp2f(-1.442695041f * x)); }

struct Params {
    const float* in[23];
    float* out; unsigned char* ws;
    int ph_lo, ph_hi;
};

template <bool NT  >
__device__ __forceinline__ void p0_transpose_item(const float* W, int K, int N, bf16* WT, int ldt, LAS float* scr, int item, int lane) {
    const int nblk = N / 32, kb = item / nblk, nb = item % nblk, k0 = 64 * kb, n0 = 32 * nb;
#ifndef P0_UNROLL
#define P0_UNROLL 16
#endif
#pragma unroll
    for (int i0 = 0; i0 < 32; i0 += P0_UNROLL) { float wv[P0_UNROLL];
#pragma unroll
        for (int i = 0; i < P0_UNROLL; ++i) wv[i] = __builtin_nontemporal_load(&W[(size_t)(k0 + 2 * (i0 + i) + (lane >> 5)) * N + n0 + (lane & 31)]);
#pragma unroll
        for (int i = 0; i < P0_UNROLL; ++i) scr[(2 * (i0 + i) + (lane >> 5)) * 33 + (lane & 31)] = wv[i]; }
    LDS_WAIT(); asm volatile("" ::: "memory");
    const int c = lane & 7;
#pragma unroll
    for (int j = 0; j < 4; ++j) { const int n = (lane >> 3) + 8 * j; const LAS float* s = scr + (8 * c) * 33 + n;
        v4u o; o.x = pk2(s[0 * 33], s[1 * 33]); o.y = pk2(s[2 * 33], s[3 * 33]); o.z = pk2(s[4 * 33], s[5 * 33]); o.w = pk2(s[6 * 33], s[7 * 33]);
        if (NT) __builtin_nontemporal_store(o, (v4u*)(WT + (size_t)(n0 + n) * ldt + k0 + 8 * c)); else *(v4u*)(WT + (size_t)(n0 + n) * ldt + k0 + 8 * c) = o; }
    LDS_WAIT(); asm volatile("" ::: "memory");
}
__device__ __forceinline__ void tr_load(const float* Wt  , int N, int lane, float (&wv)[32]) {
#pragma unroll
    for (int i = 0; i < 32; ++i) wv[i] = __builtin_nontemporal_load(&Wt[(size_t)(2 * i + (lane >> 5)) * N + (lane & 31)]);
}
__device__ __forceinline__ void tr_store(bf16* WTt  , int ldt, int lane, const float (&wv)[32], LAS float* scr) {
#pragma unroll
    for (int i = 0; i < 32; ++i) scr[(2 * i + (lane >> 5)) * 33 + (lane & 31)] = wv[i];
    LDS_WAIT(); asm volatile("" ::: "memory");
    const int c = lane & 7;
#pragma unroll
    for (int j = 0; j < 4; ++j) { const int n = (lane >> 3) + 8 * j; const LAS float* s = scr + (8 * c) * 33 + n;
        v4u o; o.x = pk2(s[0 * 33], s[1 * 33]); o.y = pk2(s[2 * 33], s[3 * 33]); o.z = pk2(s[4 * 33], s[5 * 33]); o.w = pk2(s[6 * 33], s[7 * 33]);
        __builtin_nontemporal_store(o, (v4u*)(WTt + (size_t)n * ldt + 8 * c)); }
    LDS_WAIT(); asm volatile("" ::: "memory");
}
constexpr int I_FF2 = (DFF / 64) * (DM / 32), I_FF1 = (DM / 64) * (DFF / 32), I_IN = (DM / 64) * (DIN / 32), I_OUT = (DM / 64) * (DM / 32), I_G = 32 * 8;
constexpr int I_TOTAL = I_FF2 + I_FF1 + I_IN + I_OUT + I_G;
constexpr int I_DEFER = 12288, I_FF2_DEF = 4096;
constexpr int I_P0 = I_TOTAL - I_DEFER;
static_assert(I_FF1 + I_FF2_DEF == I_DEFER && I_DEFER == 256 * 6 * 8 && I_P0 == 256 * 41, "deferred weight-copy split");
constexpr int GEMV_CNT_WORD = 3600;

__device__ __forceinline__ void phase0(const Params& P, LAS unsigned char* lds) {
    const int tid = threadIdx.x, lane = tid & 63, wave = __builtin_amdgcn_readfirstlane(tid >> 6);
    const int G = gridDim.x, bx = blockIdx.x;
    unsigned char* ws = P.ws;
    {
        LAS float* s = (LAS float*)(lds + 67584);
        LAS float* red = (LAS float*)(lds + 108544);
        for (int i = tid; i < NCOND * DM; i += NTHR) { const int j = i >> 11, k = i & 2047; const float cv = (j == 0) ? P.in[4][k] : P.in[2][(j - 1) * DM + k];
            s[i] = cv * sigmoidf_(cv); }
        __syncthreads();
        for (int cb = bx; cb < 256; cb += G) {
            const int c4 = lane & 15, sub = lane >> 4, n0 = cb * 48; const bool act = c4 < 12;
            f32x4 acc[NCOND];
#pragma unroll
            for (int j = 0; j < NCOND; ++j) acc[j] = (f32x4){0.f, 0.f, 0.f, 0.f};
            const float* wp = P.in[6] + (size_t)(wave * 4 + sub) * NMOD6 + n0 + (act ? c4 : 0) * 4;
#pragma unroll 8
            for (int i = 0; i < 64; ++i) { const int r = i * 32 + wave * 4 + sub; const f32x4 wv = __builtin_nontemporal_load((const f32x4*)(wp + (size_t)i * 32 * NMOD6));
#pragma unroll
                for (int j = 0; j < NCOND; ++j) acc[j] += s[j * DM + r] * wv; }
#pragma unroll
            for (int j = 0; j < NCOND; ++j)
#pragma unroll
                for (int e = 0; e < 4; ++e) { float v = acc[j][e]; v += __shfl_xor(v, 16); v += __shfl_xor(v, 32); if (sub == 0 && act) red[(wave * NCOND + j) * 48 + c4 * 4 + e] = v; }
            __syncthreads();
            if (tid < NCOND * 48) { const int j = tid / 48, cc = tid - j * 48; float v = P.in[7][n0 + cc];
#pragma unroll
                for (int w = 0; w < 8; ++w) v += red[(w * NCOND + j) * 48 + cc];
                __hip_atomic_store((float*)(ws + WS_MOD) + j * NMOD6 + n0 + cc, v, __ATOMIC_RELAXED, __HIP_MEMORY_SCOPE_AGENT); }
            __syncthreads();
        }
        asm volatile("s_waitcnt vmcnt(0)" ::: "memory"); __syncthreads();
        if (tid == 0) __hip_atomic_fetch_add((unsigned*)ws + GEMV_CNT_WORD, 1u, __ATOMIC_RELAXED, __HIP_MEMORY_SCOPE_AGENT);
    }
    LAS float* scr = (LAS float*)(lds + wave * 8448);
    const int per = (I_P0 + G - 1) / G, start = bx * per;
    for (int q = wave; q < per; q += NWAVES) {
        int r = start + q; if (r >= I_P0) break;
        if (r < I_FF2 - I_FF2_DEF) { p0_transpose_item<true>(P.in[21], DFF, DM, (bf16*)(ws + WS_WFF2), LD8, scr, r + I_FF2_DEF, lane); continue; } r -= I_FF2 - I_FF2_DEF;
        if (r < I_IN) { p0_transpose_item<false>(P.in[8], DM, DIN, (bf16*)(ws + WS_WIN), LD2, scr, r, lane); continue; } r -= I_IN;
        if (r < I_OUT) { p0_transpose_item<true>(P.in[18], DM, DM, (bf16*)(ws + WS_WOUT), LD2, scr, r, lane); continue; } r -= I_OUT;
        { const int mat = r >> 3, it = r & 7, type = mat & 1, dh = mat >> 1;
          p0_transpose_item<false>((type ? P.in[13] : P.in[11]) + (size_t)dh * 16384, 128, 128, (bf16*)(ws + WS_GWT) + (size_t)mat * 16384, 128, scr, it, lane); }
    }
}
#define TR_DEFERRED(it, b, w, Wt, WTt, Nn, Ld) do { const bool _f1 = (it) < 4; const float* _W = _f1 ? P.in[20] : P.in[21]; bf16* _WT = (bf16*)(P.ws + (_f1 ? WS_WFF1 : WS_WFF2)); \
        Nn = _f1 ? DFF : DM; Ld = _f1 ? LD2 : LD8; const int _item = (((it) - (_f1 ? 0 : 4)) * 256 + (b)) * 8 + (w); \
        const int _nblk = Nn / 32, _k0 = 64 * (_item / _nblk), _n0 = 32 * (_item % _nblk); \
        Wt = _W + (size_t)_k0 * Nn + _n0; WTt = _WT + (size_t)_n0 * Ld + _k0; } while (0)
__device__ __forceinline__ void gemv_wait(const Params& P) {
    if (threadIdx.x == 0) { unsigned* w = (unsigned*)P.ws + GEMV_CNT_WORD; unsigned sp = 0;
        while (__hip_atomic_load(w, __ATOMIC_RELAXED, __HIP_MEMORY_SCOPE_AGENT) < gridDim.x) { __builtin_amdgcn_s_sleep(2); if (++sp > (1u << 22)) break; }
        __builtin_amdgcn_fence(__ATOMIC_ACQUIRE, "agent"); asm volatile("s_waitcnt vmcnt(0)" ::: "memory"); }
    __syncthreads();
}

constexpr int HEAD_CNT_WORD = 3616;
__device__ __forceinline__ void head_publish(const Params& P) {
    asm volatile("s_waitcnt vmcnt(0)" ::: "memory"); __syncthreads();
    if (threadIdx.x == 0)
        __hip_atomic_fetch_add((unsigned*)P.ws + HEAD_CNT_WORD + 8 * (blockIdx.x & 7), 1u, __ATOMIC_RELAXED, __HIP_MEMORY_SCOPE_AGENT);
}
__device__ __forceinline__ void head_wait(const Params& P) {
    asm volatile("s_waitcnt vmcnt(0)" ::: "memory"); __syncthreads();
    if (threadIdx.x == 0) { unsigned* w = (unsigned*)P.ws + HEAD_CNT_WORD + 8 * (blockIdx.x & 7); unsigned sp = 0;
        while (__hip_atomic_load(w, __ATOMIC_RELAXED, __HIP_MEMORY_SCOPE_AGENT) < (gridDim.x >> 3)) { __builtin_amdgcn_s_sleep(2); if (++sp > (1u << 22)) break; }
        __builtin_amdgcn_fence(__ATOMIC_ACQUIRE, "agent"); asm volatile("s_waitcnt vmcnt(0)" ::: "memory"); }
    __syncthreads();
}

template <int WHICH  >
__device__ __forceinline__ void norm_mod_phase(const Params& P) {
    const int tid = threadIdx.x, lane = tid & 63, wave = __builtin_amdgcn_readfirstlane(tid >> 6);
    const int gw = blockIdx.x * NWAVES + wave, NGW = gridDim.x * NWAVES;
    const int per = (MTOK + NGW - 1) / NGW;
    const float* mod = (const float*)(P.ws + WS_MOD);
    const float* g = WHICH == 1 ? P.in[5] : P.in[19];
    const int sh_off = WHICH == 1 ? 0 : 3 * DM, sc_off = sh_off + DM;
    bf16* H = (bf16*)(P.ws + WS_H);
    int cur = -1; f32x4 cm[8], sh[8], vn[8];
    const int r0 = gw * per, r1 = ((gw + 1) * per < MTOK) ? (gw + 1) * per : MTOK;
#define NM_XROW(r) ((r) < NCTX ? P.in[0] + (size_t)(r) * DM : P.in[1] + (size_t)((r) - NCTX) * DM)
    if (r0 < r1) { const float* xr = NM_XROW(r0);
#pragma unroll
        for (int j = 0; j < 8; ++j) vn[j] = __builtin_nontemporal_load((const f32x4*)xr + lane + 64 * j); }
    for (int row = r0; row < r1; ++row) {
        const int cond = row < NCTX ? 0 : 1 + ((row - NCTX) >> 11);
        if (cond != cur) { cur = cond;
#pragma unroll
            for (int j = 0; j < 8; ++j) { const f32x4 g4 = ((const f32x4*)g)[lane + 64 * j], s4 = ((const f32x4*)(mod + cond * NMOD6 + sc_off))[lane + 64 * j];
                cm[j] = g4 * (s4 + 1.0f); sh[j] = ((const f32x4*)(mod + cond * NMOD6 + sh_off))[lane + 64 * j]; } }
        f32x4 v[8]; float ss = 0.f;
#pragma unroll
        for (int j = 0; j < 8; ++j) v[j] = vn[j];
        if (row + 1 < r1) { const float* xr = NM_XROW(row + 1);
#pragma unroll
            for (int j = 0; j < 8; ++j) vn[j] = __builtin_nontemporal_load((const f32x4*)xr + lane + 64 * j); }
        if (WHICH == 2) {
            const v2u* dr = (const v2u*)((const bf16*)(P.ws + WS_D1) + (size_t)row * DM) + lane;
#pragma unroll
            for (int j = 0; j < 8; ++j) { const v2u d = __builtin_nontemporal_load(dr + 64 * j); v[j] += (f32x4){bflo(d.x), bfhi(d.x), bflo(d.y), bfhi(d.y)}; }
            if (row >= 8192) { const v2u* pr = (const v2u*)((const bf16*)(P.ws + WS_PART) + (size_t)(row - 8192) * DM) + lane;
#pragma unroll
                for (int j = 0; j < 8; ++j) { const v2u d = __builtin_nontemporal_load(pr + 64 * j); v[j] += (f32x4){bflo(d.x), bfhi(d.x), bflo(d.y), bfhi(d.y)}; } }
            v2u* xw = (v2u*)((bf16*)(P.ws + (row < 6144 ? WS_X1A : WS_X1B)) + (size_t)(row < 6144 ? row : row - 6144) * DM) + lane;
#pragma unroll
            for (int j = 0; j < 8; ++j) { v2u w; w.x = pk2(v[j].x, v[j].y); w.y = pk2(v[j].z, v[j].w); __builtin_nontemporal_store(w, xw + 64 * j); } }
#pragma unroll
        for (int j = 0; j < 8; ++j) ss += (v[j].x * v[j].x + v[j].y * v[j].y) + (v[j].z * v[j].z + v[j].w * v[j].w);
        const float rinv = 1.0f / sqrtf(wave_sum(ss) * (1.0f / DM) + EPSN);
        v2u* o8 = (v2u*)(H + (size_t)row * LD2) + lane;
#pragma unroll
        for (int j = 0; j < 8; ++j) { const f32x4 y = v[j] * rinv * cm[j] + sh[j]; v2u w; w.x = pk2(y.x, y.y); w.y = pk2(y.z, y.w); o8[64 * j] = w; }
    }
}
__device__ __forceinline__ void final_norm_phase(const Params& P, float* dst) {
    const int tid = threadIdx.x, lane = tid & 63, wave = __builtin_amdgcn_readfirstlane(tid >> 6);
    const int gw = blockIdx.x * NWAVES + wave, NGW = gridDim.x * NWAVES;
    f32x4 g4[8];
#pragma unroll
    for (int j = 0; j < 8; ++j) g4[j] = ((const f32x4*)P.in[22])[lane + 64 * j];
    v2u vn[8];
#define FN_X1ROW(r) ((const v2u*)((const bf16*)(P.ws + ((r) < 6144 ? WS_X1A : WS_X1B)) + (size_t)((r) < 6144 ? (r) : (r) - 6144) * DM) + lane)
    if (gw < MTOK) { const v2u* xr0 = FN_X1ROW(gw);
#pragma unroll
        for (int j = 0; j < 8; ++j) vn[j] = __builtin_nontemporal_load(xr0 + 64 * j); }
    for (int row = gw; row < MTOK; row += NGW) {
        f32x4 v[8]; float ss = 0.f;
#pragma unroll
        for (int j = 0; j < 8; ++j) v[j] = (f32x4){bflo(vn[j].x), bfhi(vn[j].x), bflo(vn[j].y), bfhi(vn[j].y)};
        if (row + NGW < MTOK) { const v2u* xr1 = FN_X1ROW(row + NGW);
#pragma unroll
            for (int j = 0; j < 8; ++j) vn[j] = __builtin_nontemporal_load(xr1 + 64 * j); }
        { const v2u* dr = (const v2u*)((const bf16*)(P.ws + WS_D2) + (size_t)row * DM) + lane;
#pragma unroll
            for (int j = 0; j < 8; ++j) { const v2u d = __builtin_nontemporal_load(dr + 64 * j); v[j] += (f32x4){bflo(d.x), bfhi(d.x), bflo(d.y), bfhi(d.y)}; } }
        if (row >= 8192) { const v2u* pr = (const v2u*)((const bf16*)(P.ws + WS_PART) + (size_t)(row - 8192) * DM) + lane;
#pragma unroll
            for (int j = 0; j < 8; ++j) { const v2u d = __builtin_nontemporal_load(pr + 64 * j); v[j] += (f32x4){bflo(d.x), bfhi(d.x), bflo(d.y), bfhi(d.y)}; } }
#pragma unroll
        for (int j = 0; j < 8; ++j) ss += (v[j].x * v[j].x + v[j].y * v[j].y) + (v[j].z * v[j].z + v[j].w * v[j].w);
        const float rinv = 1.0f / sqrtf(wave_sum(ss) * (1.0f / DM) + EPSN);
        f32x4* xo = (f32x4*)(dst + (size_t)row * DM) + lane;
#pragma unroll
        for (int j = 0; j < 8; ++j) __builtin_nontemporal_store(v[j] * rinv * g4[j], xo + 64 * j);
    }
}

constexpr int XCA_P = 136;
constexpr int XCF_P = 132;
constexpr int L_XCA = 0, L_XCF = 17408, L_CW = 51200, L_HT = 53760;
static_assert(L_XCF == 64 * XCA_P * 2 && L_CW == L_XCF + 64 * XCF_P * 4 && L_HT == L_CW + 5 * 128 * 4 && L_HT + 2 * 64 * XCF_P * 4 <= 131072 && 32 * 256 * 8 <= 2 * 64 * XCF_P * 4, "rg LDS map");

template <bool REV>
__device__ __forceinline__ void scan_chunk(const LAS bf16* XCA, const LAS float* XCF, v4u* ABw, const bf16x8 (&Br)[2][4], const bf16x8 (&Bi)[2][4],
                                           const float (&bA)[2], const float (&bI)[2], const float (&sp)[2], float (&cout)[2], float (&pout)[2], int fr, int fq, int q) {
    float carry[2] = {0.f, 0.f}, ptot[2] = {1.0f, 1.0f};
#pragma unroll
    for (int mm = 0; mm < 4; ++mm) { const int m = REV ? 3 - mm : mm;
        f32x4 ar[2], ai[2];
#pragma unroll
        for (int n = 0; n < 2; ++n) { ar[n] = (f32x4){0.f, 0.f, 0.f, 0.f}; ai[n] = (f32x4){0.f, 0.f, 0.f, 0.f}; }
#pragma unroll
        for (int ks = 0; ks < 4; ++ks) { const bf16x8 a = *(const LAS bf16x8*)(XCA + (m * 16 + fr) * XCA_P + ks * 32 + fq * 8);
#pragma unroll
            for (int n = 0; n < 2; ++n) { ar[n] = __builtin_amdgcn_mfma_f32_16x16x32_bf16(a, Br[n][ks], ar[n], 0, 0, 0); ai[n] = __builtin_amdgcn_mfma_f32_16x16x32_bf16(a, Bi[n][ks], ai[n], 0, 0, 0); } }
#pragma unroll
        for (int n = 0; n < 2; ++n) {
            float la[4], bb[4];
            v4u w;
#pragma unroll
            for (int h = 0; h < 2; ++h) {
                const f32x2 kk = (f32x2){-1.442695041f, -1.442695041f}, one = (f32x2){1.0f, 1.0f};
                const f32x2 rp = (f32x2){ar[n][2 * h], ar[n][2 * h + 1]}, ip = (f32x2){ai[n][2 * h], ai[n][2 * h + 1]};
                const f32x2 tr = rp * kk + (f32x2){bA[n], bA[n]}, ti = ip * kk + (f32x2){bI[n], bI[n]};
                f32x2 er, ei; er.x = __builtin_amdgcn_exp2f(tr.x); er.y = __builtin_amdgcn_exp2f(tr.y); ei.x = __builtin_amdgcn_exp2f(ti.x); ei.y = __builtin_amdgcn_exp2f(ti.y);
                const f32x2 dr = er + one, v = ei + one;
                f32x2 rc; rc.x = __builtin_amdgcn_rcpf(dr.x); rc.y = __builtin_amdgcn_rcpf(dr.y);
                const f32x2 l2 = rc * (f32x2){sp[n], sp[n]};
                const unsigned wl = pk2(l2.x, l2.y);
                f32x2 a; a.x = __builtin_amdgcn_exp2f(bflo(wl)); a.y = __builtin_amdgcn_exp2f(bfhi(wl));
                f32x2 u = one - a * a; u.x = fmaxf(u.x, 1e-30f); u.y = fmaxf(u.y, 1e-30f);
                const f32x2 uv = u * v * v;
                f32x2 rs; rs.x = __builtin_amdgcn_rsqf(uv.x); rs.y = __builtin_amdgcn_rsqf(uv.y);
                const f32x2 xc = (f32x2){XCF[(m * 16 + fq * 4 + 2 * h) * XCF_P + q * 32 + n * 16 + fr], XCF[(m * 16 + fq * 4 + 2 * h + 1) * XCF_P + q * 32 + n * 16 + fr]};
                const f32x2 b = u * rs * xc;
                const unsigned wb = pk2(b.x, b.y);
                la[2 * h] = a.x; la[2 * h + 1] = a.y; bb[2 * h] = bflo(wb); bb[2 * h + 1] = bfhi(wb);
                if (h == 0) { w.x = wl; w.z = wb; } else { w.y = wl; w.w = wb; }
            }
            __builtin_nontemporal_store(w, ABw + (m * 2 + n) * 64);
            float Pl = 1.0f, Hl = 0.0f;
#pragma unroll
            for (int jj = 0; jj < 4; ++jj) { const int j = REV ? 3 - jj : jj; Hl = la[j] * Hl + bb[j]; Pl *= la[j]; }
#pragma unroll
            for (int kk = 0; kk < 4; ++kk) { const int k = REV ? 3 - kk : kk;
                const float Pk = __shfl(Pl, fr + 16 * k), Hk = __shfl(Hl, fr + 16 * k);
                carry[n] = Pk * carry[n] + Hk; ptot[n] *= Pk; }
        }
    }
    cout[0] = carry[0]; cout[1] = carry[1]; pout[0] = ptot[0]; pout[1] = ptot[1];
}
template <bool REV>
__device__ __forceinline__ void scan_final(const v4u (&ab)[8], LAS float* HTd, const float (&cin)[2], float (&cout)[2], int fr, int fq, int q) {
    float carry[2] = {cin[0], cin[1]};
#pragma unroll
    for (int mm = 0; mm < 4; ++mm) { const int m = REV ? 3 - mm : mm;
#pragma unroll
        for (int n = 0; n < 2; ++n) { const v4u w = ab[m * 2 + n];
            float la[4] = {bflo(w.x), bfhi(w.x), bflo(w.y), bfhi(w.y)}; const float bb[4] = {bflo(w.z), bfhi(w.z), bflo(w.w), bfhi(w.w)};
#pragma unroll
            for (int j = 0; j < 4; ++j) la[j] = __builtin_amdgcn_exp2f(la[j]);
            float Pl = 1.0f, Hl = 0.0f;
#pragma unroll
            for (int jj = 0; jj < 4; ++jj) { const int j = REV ? 3 - jj : jj; Hl = la[j] * Hl + bb[j]; Pl *= la[j]; }
            float my = 0.0f;
#pragma unroll
            for (int kk = 0; kk < 4; ++kk) { const int k = REV ? 3 - kk : kk;
                const float Pk = __shfl(Pl, fr + 16 * k), Hk = __shfl(Hl, fr + 16 * k);
                if (k == fq) my = carry[n];
                carry[n] = Pk * carry[n] + Hk; }
            float h = my;
#pragma unroll
            for (int jj = 0; jj < 4; ++jj) { const int j = REV ? 3 - jj : jj; h = la[j] * h + bb[j]; HTd[(m * 16 + fq * 4 + j) * XCF_P + q * 32 + n * 16 + fr] = h; }
        }
    }
    cout[0] = carry[0]; cout[1] = carry[1];
}

__device__ __forceinline__ void rg_phase1(const Params& P, LAS unsigned char* lds) {
    const int tid = threadIdx.x, lane = tid & 63, wave = __builtin_amdgcn_readfirstlane(tid >> 6), fr = lane & 15, fq = lane >> 4;
    const int head = blockIdx.x & 7, jb = blockIdx.x >> 3, nb = gridDim.x >> 3;
    const int dir = wave >> 2, q = wave & 3;
    unsigned char* ws = P.ws;
    const bf16* proj = (const bf16*)(ws + WS_PROJ);
    f32x2* summ = (f32x2*)(ws + WS_SUMM);
    v4u* AB = (v4u*)(ws + (dir == 0 ? WS_AB0 : WS_AB1));
    LAS bf16* XCA = (LAS bf16*)(lds + L_XCA);
    LAS float* XCF = (LAS float*)(lds + L_XCF);
    LAS float* CW = (LAS float*)(lds + L_CW);
    const bf16* gwr = (const bf16*)(ws + WS_GWT) + (size_t)((dir * 8 + head) * 2) * 16384, * gwi = gwr + 16384;
    bf16x8 Br[2][4], Bi[2][4];
#pragma unroll
    for (int n = 0; n < 2; ++n)
#pragma unroll
        for (int ks = 0; ks < 4; ++ks) { const int off = (q * 32 + n * 16 + fr) * 128 + ks * 32 + fq * 8; Br[n][ks] = *(const bf16x8*)(gwr + off); Bi[n][ks] = *(const bf16x8*)(gwi + off); }
    float bA[2], bI[2], sp[2];
#pragma unroll
    for (int n = 0; n < 2; ++n) { const int ch = dir * DRG + head * 128 + q * 32 + n * 16 + fr; bA[n] = -1.442695041f * P.in[12][ch]; bI[n] = -1.442695041f * P.in[14][ch]; sp[n] = -1.442695041f * 8.0f * log1pf(__expf(-P.in[15][ch])); }
    for (int i = tid; i < 5 * 128; i += NTHR) { const int k = i >> 7, c = i & 127; CW[i] = k < 4 ? P.in[9][k * DRG + head * 128 + c] : P.in[10][head * 128 + c]; }
    __syncthreads();
    v4u xr[4][2];
#define RG_LOAD_ITEM(cc) do { const int _row0 = (cc) * 64; int _s0, _s1; if (_row0 < NCTX) { _s0 = _row0 & ~255; _s1 = _s0 + 256; } else { _s0 = NCTX + ((_row0 - NCTX) & ~2047); _s1 = _s0 + 2048; } \
        const int _tl = tid >> 3, _c0 = (tid & 7) * 16; \
        _Pragma("unroll") for (int k = 0; k < 4; ++k) { const int r = _row0 + _tl + k - 2; xr[k][0] = (v4u){0u, 0u, 0u, 0u}; xr[k][1] = (v4u){0u, 0u, 0u, 0u}; \
            if (r >= _s0 && r < _s1) { const v4u* src = (const v4u*)(proj + (size_t)r * DIN + DRG + head * 128 + _c0); xr[k][0] = src[0]; xr[k][1] = src[1]; } } \
        } while (0)
    for (int c = jb; c < NCHUNK64; c += nb) {
        RG_LOAD_ITEM(c);
        { const int tl = tid >> 3, c0 = (tid & 7) * 16;
          float xv[16];
#pragma unroll
          for (int e4 = 0; e4 < 4; ++e4) { const f32x4 b4 = *(const LAS f32x4*)(CW + 4 * 128 + c0 + 4 * e4); xv[4 * e4] = b4.x; xv[4 * e4 + 1] = b4.y; xv[4 * e4 + 2] = b4.z; xv[4 * e4 + 3] = b4.w; }
#pragma unroll
          for (int k = 0; k < 4; ++k) { const v4u x0 = xr[k][0], x1 = xr[k][1];
              const unsigned xw[8] = {x0.x, x0.y, x0.z, x0.w, x1.x, x1.y, x1.z, x1.w};
#pragma unroll
              for (int e2 = 0; e2 < 8; ++e2) { const f32x2 w2 = *(const LAS f32x2*)(CW + k * 128 + c0 + 2 * e2); xv[2 * e2] += w2.x * bflo(xw[e2]); xv[2 * e2 + 1] += w2.y * bfhi(xw[e2]); } }
#pragma unroll
          for (int e4 = 0; e4 < 4; ++e4) *(LAS f32x4*)(XCF + tl * XCF_P + c0 + 4 * e4) = (f32x4){xv[4 * e4], xv[4 * e4 + 1], xv[4 * e4 + 2], xv[4 * e4 + 3]};
          v4u a0, a1; a0.x = pk2(xv[0], xv[1]); a0.y = pk2(xv[2], xv[3]); a0.z = pk2(xv[4], xv[5]); a0.w = pk2(xv[6], xv[7]);
          a1.x = pk2(xv[8], xv[9]); a1.y = pk2(xv[10], xv[11]); a1.z = pk2(xv[12], xv[13]); a1.w = pk2(xv[14], xv[15]);
          *(LAS v4u*)(XCA + tl * XCA_P + c0) = a0; *(LAS v4u*)(XCA + tl * XCA_P + c0 + 8) = a1; }
        const int trit = (c - jb) / nb;
        float trv[32];
        const bool tr_on = (gridDim.x == 256);
        const float* trW; bf16* trWT; int trN, trLd;
        TR_DEFERRED(trit, (int)blockIdx.x, wave, trW, trWT, trN, trLd);
        if (tr_on) tr_load(trW, trN, lane, trv);
        __syncthreads();
        float cout[2], pout[2];
        v4u* ABw = AB + ((size_t)((c * 8 + head) * 4 + q) * 8) * 64 + lane;
        if (dir == 0) scan_chunk<false>(XCA, XCF, ABw, Br, Bi, bA, bI, sp, cout, pout, fr, fq, q);
        else scan_chunk<true>(XCA, XCF, ABw, Br, Bi, bA, bI, sp, cout, pout, fr, fq, q);
        if (fq == 0) {
#pragma unroll
            for (int n = 0; n < 2; ++n)
                __hip_atomic_store((unsigned long long*)(summ + ((size_t)(dir * NCHUNK64 + c) * 8 + head) * 128 + q * 32 + n * 16 + fr),
                                   ((unsigned long long)__builtin_bit_cast(unsigned, cout[n]) << 32) | __builtin_bit_cast(unsigned, pout[n]), __ATOMIC_RELAXED, __HIP_MEMORY_SCOPE_AGENT); }
        if (tr_on) tr_store(trWT, trLd, lane, trv, (LAS float*)(lds + L_HT + wave * 8448));
        __syncthreads();
    }
    if (gridDim.x != 256) {
        LAS float* scr = (LAS float*)(lds + L_HT + wave * 8448);
        for (int d = blockIdx.x * NWAVES + wave; d < 256 * 6 * NWAVES; d += gridDim.x * NWAVES) { const int w_ = d & 7, it_ = (d >> 3) % 6, b_ = (d >> 3) / 6; const float* tw_; bf16* twt_; int tn_, tl_; TR_DEFERRED(it_, b_, w_, tw_, twt_, tn_, tl_); float wv[32]; tr_load(tw_, tn_, lane, wv); tr_store(twt_, tl_, lane, wv, scr); }
    }
#undef RG_LOAD_ITEM
}
__device__ __forceinline__ void rg_phase2(const Params& P, LAS unsigned char* lds) {
    const int tid = threadIdx.x, lane = tid & 63, wave = __builtin_amdgcn_readfirstlane(tid >> 6), fr = lane & 15, fq = lane >> 4;
    const int head = blockIdx.x & 7, jb = blockIdx.x >> 3, nb = gridDim.x >> 3;
    const int dir = wave >> 2, q = wave & 3;
    unsigned char* ws = P.ws;
    const bf16* proj = (const bf16*)(ws + WS_PROJ);
    bf16* mix = (bf16*)(ws + WS_MIX);
    const f32x2* summ = (const f32x2*)(ws + WS_SUMM);
    const v4u* AB = (const v4u*)(ws + (dir == 0 ? WS_AB0 : WS_AB1));
    LAS f32x2* CARRY = (LAS f32x2*)lds;
    LAS float* HT = (LAS float*)(lds + 63488);
    static_assert(31 * 256 * 8 == 63488 && 63488 + 2 * 64 * XCF_P * 4 <= 131072, "pass-2 LDS map");
    v4u abn[8]; f32x4 cpre[8];
#define RG_LOAD_AB(cc) do { const v4u* _s = AB + ((size_t)(((cc) * 8 + head) * 4 + q) * 8) * 64 + lane; _Pragma("unroll") for (int i = 0; i < 8; ++i) abn[i] = __builtin_nontemporal_load(_s + i * 64); } while (0)
#define RG_SEQ(cc, CS0, CS1) const int _r0 = (cc) * 64; int _q0, _q1; if (_r0 < NCTX) { _q0 = _r0 & ~255; _q1 = _q0 + 256; } else { _q0 = NCTX + ((_r0 - NCTX) & ~2047); _q1 = _q0 + 2048; } const int CS0 = _q0 >> 6, CS1 = _q1 >> 6
#define RG_LOAD_CARRY(cc) do { RG_SEQ(cc, _c0, _c1); const int _nf = (cc) - _c0, _nb = _c1 - 1 - (cc), _nst = _nf > _nb ? _nf : _nb; \
        _Pragma("unroll") for (int k = 0; k < 8; ++k) { const int idx = tid + NTHR * k; cpre[k] = (f32x4){1.f, 0.f, 1.f, 0.f}; \
            if (idx < _nst * 128) { const int i = idx >> 7, u = idx & 127, d = u >> 6, ch = (u & 63) * 2; const int c2 = d == 0 ? _c0 + i : _c1 - 1 - i; const bool valid = d == 0 ? (c2 < (cc)) : (c2 > (cc)); \
                if (valid) cpre[k] = *(const f32x4*)(summ + ((size_t)(d * NCHUNK64 + c2) * 8 + head) * 128 + ch); } } } while (0)
    if (jb < NCHUNK64) { RG_LOAD_AB(jb); RG_LOAD_CARRY(jb); }
    for (int c = jb; c < NCHUNK64; c += nb) {
        const int row0 = c * 64;
        RG_SEQ(c, cs0, cs1);
        v4u ab[8];
#pragma unroll
        for (int i = 0; i < 8; ++i) ab[i] = abn[i];
        { const int nf = c - cs0, nbk = cs1 - 1 - c, nst = nf > nbk ? nf : nbk;
#pragma unroll
          for (int k = 0; k < 8; ++k) { const int idx = tid + NTHR * k; if (idx < nst * 128) { const int i = idx >> 7, u = idx & 127; *(LAS f32x4*)(CARRY + i * 256 + (u >> 6) * 128 + (u & 63) * 2) = cpre[k]; } } }
        if (c + nb < NCHUNK64) { RG_LOAD_AB(c + nb); RG_LOAD_CARRY(c + nb); }
        v4u gyc[2];
        { const v4u* gsrc = (const v4u*)(proj + (size_t)(row0 + (tid >> 3)) * DIN + head * 128 + (tid & 7) * 16); gyc[0] = __builtin_nontemporal_load(gsrc); gyc[1] = __builtin_nontemporal_load(gsrc + 1); }
        __syncthreads();
        float cin[2] = {0.f, 0.f}, cout[2];
        if (row0 >= NCTX) { const int bl = (row0 - NCTX) >> 11;
#pragma unroll
            for (int n = 0; n < 2; ++n) cin[n] = P.in[3][(bl * 2 + dir) * DRG + head * 128 + q * 32 + n * 16 + fr]; }
        { const int my_n = dir == 0 ? c - cs0 : cs1 - 1 - c;
          for (int i = 0; i < my_n; ++i) {
#pragma unroll
              for (int n = 0; n < 2; ++n) { const f32x2 ph = CARRY[i * 256 + dir * 128 + q * 32 + n * 16 + fr]; cin[n] = ph.x * cin[n] + ph.y; } } }
        if (dir == 0) scan_final<false>(ab, HT, cin, cout, fr, fq, q); else scan_final<true>(ab, HT + 64 * XCF_P, cin, cout, fr, fq, q);
        if (row0 < NCTX && fq == 0) { const int bb = row0 >> 8, ci = c & 3;
            if ((dir == 0 && ci == 3) || (dir == 1 && ci == 0)) {
#pragma unroll
                for (int n = 0; n < 2; ++n) P.out[(size_t)MTOK * DM + (bb * 2 + dir) * DRG + head * 128 + q * 32 + n * 16 + fr] = cout[n]; } }
        __syncthreads();
        { const int tl = tid >> 3, c0 = (tid & 7) * 16;
          const v4u g0 = gyc[0], g1 = gyc[1];
          const unsigned gw_[8] = {g0.x, g0.y, g0.z, g0.w, g1.x, g1.y, g1.z, g1.w};
          unsigned ow[8];
#pragma unroll
          for (int e4 = 0; e4 < 4; ++e4) { const f32x4 hf = *(const LAS f32x4*)(HT + tl * XCF_P + c0 + 4 * e4), hb = *(const LAS f32x4*)(HT + (64 + tl) * XCF_P + c0 + 4 * e4);
              const f32x4 hs = hf + hb;
              ow[2 * e4] = pk2(pg8::gelu_tanh(bflo(gw_[2 * e4])) * hs.x, pg8::gelu_tanh(bfhi(gw_[2 * e4])) * hs.y);
              ow[2 * e4 + 1] = pk2(pg8::gelu_tanh(bflo(gw_[2 * e4 + 1])) * hs.z, pg8::gelu_tanh(bfhi(gw_[2 * e4 + 1])) * hs.w); }
          v4u* dst = (v4u*)(mix + (size_t)(row0 + tl) * LD2 + head * 128 + c0);
          dst[0] = (v4u){ow[0], ow[1], ow[2], ow[3]}; dst[1] = (v4u){ow[4], ow[5], ow[6], ow[7]}; }
    }
    __syncthreads();
#undef RG_LOAD_AB
#undef RG_LOAD_CARRY
#undef RG_SEQ
}

constexpr int VT_P = 136;
__device__ __forceinline__ void sgu_phase(const Params& P, LAS unsigned char* lds) {
    const int tid = threadIdx.x, lane = tid & 63, wave = __builtin_amdgcn_readfirstlane(tid >> 6), fr = lane & 15, fq = lane >> 4;
    const bf16* proj = (const bf16*)(P.ws + WS_PROJ);
    bf16* mix = (bf16*)(P.ws + WS_MIX);
    LAS bf16* VT = (LAS bf16*)lds;
    for (int item = blockIdx.x; item < (MTOK / 128) * 8; item += gridDim.x) {
        const int head = item & 7, chunk = item >> 3, rowb = chunk * 128;
        const int p = wave * 16 + fr;
        const size_t tok = (size_t)(rowb + p);
        f32x4 wa[4][2];
#pragma unroll
        for (int ks = 0; ks < 4; ++ks) { const f32x4* src = (const f32x4*)(P.in[16] + (size_t)(head * 128 + p) * 128 + ks * 32 + fq * 8); wa[ks][0] = src[0]; wa[ks][1] = src[1]; }
        v2u uu[8];
#pragma unroll
        for (int n = 0; n < 8; ++n) uu[n] = __builtin_nontemporal_load((const v2u*)(proj + tok * DIN + 2 * DRG + head * 128 + n * 16 + 4 * fq));
        const float bias = P.in[17][head * 128 + p];
        { const int qp = tid >> 3, dg = tid & 7, q0 = 2 * qp;
          const v4u* s0 = (const v4u*)(proj + (size_t)(rowb + q0) * DIN + 3 * DRG + head * 128 + dg * 16);
          const v4u* s1 = (const v4u*)(proj + (size_t)(rowb + q0 + 1) * DIN + 3 * DRG + head * 128 + dg * 16);
          const v4u a0 = __builtin_nontemporal_load(s0), a1 = __builtin_nontemporal_load(s0 + 1), b0 = __builtin_nontemporal_load(s1), b1 = __builtin_nontemporal_load(s1 + 1);
          const unsigned aw[8] = {a0.x, a0.y, a0.z, a0.w, a1.x, a1.y, a1.z, a1.w}, bw[8] = {b0.x, b0.y, b0.z, b0.w, b1.x, b1.y, b1.z, b1.w};
#pragma unroll
          for (int e2 = 0; e2 < 8; ++e2) {
              *(LAS unsigned*)(VT + (dg * 16 + 2 * e2) * VT_P + q0) = pk2(pg8::gelu_tanh(bflo(aw[e2])), pg8::gelu_tanh(bflo(bw[e2])));
              *(LAS unsigned*)(VT + (dg * 16 + 2 * e2 + 1) * VT_P + q0) = pk2(pg8::gelu_tanh(bfhi(aw[e2])), pg8::gelu_tanh(bfhi(bw[e2]))); } }
        __syncthreads();
        bf16x8 A[4];
#pragma unroll
        for (int ks = 0; ks < 4; ++ks) { const f32x4 w0 = wa[ks][0], w1 = wa[ks][1];
            v4u t; t.x = pk2(w0.x, w0.y); t.y = pk2(w0.z, w0.w); t.z = pk2(w1.x, w1.y); t.w = pk2(w1.z, w1.w); A[ks] = __builtin_bit_cast(bf16x8, t); }
#pragma unroll
        for (int n = 0; n < 8; ++n) { f32x4 acc = (f32x4){0.f, 0.f, 0.f, 0.f};
#pragma unroll
            for (int ks = 0; ks < 4; ++ks) { const bf16x8 b = *(const LAS bf16x8*)(VT + (n * 16 + fr) * VT_P + ks * 32 + fq * 8); acc = __builtin_amdgcn_mfma_f32_16x16x32_bf16(b, A[ks], acc, 0, 0, 0); }
            const int d0 = n * 16 + 4 * fq;
            v2u o; o.x = pk2(pg8::gelu_tanh(bflo(uu[n].x)) * (acc.x + bias), pg8::gelu_tanh(bfhi(uu[n].x)) * (acc.y + bias));
            o.y = pk2(pg8::gelu_tanh(bflo(uu[n].y)) * (acc.z + bias), pg8::gelu_tanh(bfhi(uu[n].y)) * (acc.w + bias));
            *(v2u*)(mix + tok * LD2 + DRG + head * 128 + d0) = o; }
        __syncthreads();
    }
}

#define XB_TMO      128
#define XB_XCNT(j)  (256  + 64 * (j))
#define XB_XSUB(j)  (1280 + 64 * (j))
#define XB_XGEN(j)  (2304 + 64 * (j))
#define XB_TOP      3328
#define XB_TOPGEN   3392
#define XCD_BAR_WORDS 3456
#define XB_SPIN_CAP (1u << 18)

__device__ __forceinline__ unsigned xb_ld(unsigned* p)              { return __hip_atomic_load(p, __ATOMIC_RELAXED, __HIP_MEMORY_SCOPE_AGENT); }
__device__ __forceinline__ unsigned xb_add(unsigned* p, unsigned v) { return __hip_atomic_fetch_add(p, v, __ATOMIC_RELAXED, __HIP_MEMORY_SCOPE_AGENT); }
__device__ __forceinline__ unsigned xb_xcc_id() { return (unsigned)__builtin_amdgcn_s_getreg((3 << 11) | 20) & 0xFu; }
#define XB_SPIN(cond, bar) do { unsigned _sp = 0; while (cond) { __builtin_amdgcn_s_sleep(1); \
    if ((++_sp & 255u) == 0u) { if (xb_ld(&(bar)[XB_TMO])) break; if (_sp > XB_SPIN_CAP) { atomicAdd(&(bar)[XB_TMO], 1u); break; } } } } while (0)

struct XcdBarrier {
    unsigned* bar; unsigned x;
    volatile LAS unsigned* st;
};

__device__ __forceinline__ XcdBarrier xcd_barrier_post(unsigned* bar, volatile LAS unsigned* st) {
    XcdBarrier b; b.bar = bar; b.x = xb_xcc_id(); b.st = st;
    if (threadIdx.x == 0) (void)xb_add(&bar[XB_XCNT(b.x)], 1u);
    return b;
}
__device__ __forceinline__ void xcd_barrier_complete(unsigned* bar, unsigned x, unsigned& nloc, unsigned& nx) {
    const unsigned G = gridDim.x * gridDim.y * gridDim.z;
    unsigned sum, cnt, mine, sp = 0u;
    for (;;) {
        sum = 0u; cnt = 0u; mine = 0u;
#pragma unroll
        for (unsigned j = 0; j < 16; ++j) { const unsigned c = xb_ld(&bar[XB_XCNT(j)]); sum += c; cnt += (c > 0u) ? 1u : 0u; mine = (j == x) ? c : mine; }
        if (sum == G) break;
        __builtin_amdgcn_s_sleep(1);
        if ((++sp & 255u) == 0u) { if (xb_ld(&bar[XB_TMO])) break; if (sp > XB_SPIN_CAP) { atomicAdd(&bar[XB_TMO], 1u); break; } }
    }
    nloc = mine > 0u ? mine : 1u; nx = cnt > 0u ? cnt : 1u;
}

__device__ __forceinline__ void xcd_barrier(const XcdBarrier& b) {
    asm volatile("s_waitcnt vmcnt(0)" ::: "memory");
    __syncthreads();
    if (threadIdx.x == 0) {
        unsigned* bar = b.bar;
        __builtin_amdgcn_s_waitcnt(0);
        unsigned nloc = b.st[0], nx = b.st[1];
        if (nloc == 0u) { xcd_barrier_complete(bar, b.x, nloc, nx); b.st[0] = nloc; b.st[1] = nx; }
        const unsigned old = xb_add(&bar[XB_XSUB(b.x)], 1u);
        const unsigned gen = old / nloc;
        if (old + 1u == (gen + 1u) * nloc) {
            __builtin_amdgcn_fence(__ATOMIC_RELEASE, "agent");
            asm volatile("s_waitcnt vmcnt(0)" ::: "memory");
            const unsigned og = xb_add(&bar[XB_TOP], 1u);
            const unsigned tg = og / nx;
            if (og + 1u == (tg + 1u) * nx) xb_add(&bar[XB_TOPGEN], 1u);
            else XB_SPIN(xb_ld(&bar[XB_TOPGEN]) == tg, bar);
            __builtin_amdgcn_fence(__ATOMIC_ACQUIRE, "agent");
            xb_add(&bar[XB_XGEN(b.x)], 1u);
            asm volatile("s_waitcnt vmcnt(0)" ::: "memory");
        } else {
            XB_SPIN(xb_ld(&bar[XB_XGEN(b.x)]) == gen, bar);
            __builtin_amdgcn_fence(__ATOMIC_ACQUIRE, "agent");
            asm volatile("s_waitcnt vmcnt(0)" ::: "memory");
        }
    }
    __syncthreads();
}

constexpr int N_PHASES = 10;
__global__ void __launch_bounds__(NTHR, 2) mk_fwd(Params P) {
    extern __shared__ __attribute__((aligned(16))) unsigned char lds_raw[];
    LAS unsigned char* lds = (LAS unsigned char*)lds_raw;
    cg::grid_group grid = cg::this_grid();
    const int lo = P.ph_lo, hi = P.ph_hi, G = gridDim.x;
    unsigned char* ws = P.ws;
#define IN(k) (lo <= (k) && (k) < hi)
    volatile LAS unsigned* bst = (volatile LAS unsigned*)(lds + 131072 + 64);
    if (threadIdx.x < 2) bst[threadIdx.x] = 0u;
    __syncthreads();
    XcdBarrier xbar; xbar.bar = (unsigned*)ws; xbar.x = 0; xbar.st = bst;
    if (hi - lo > 1) xbar = xcd_barrier_post((unsigned*)ws, bst);
    if (lo < 0) grid.sync();
#define SEAM(k) do { if (IN(k) && IN((k) + 1)) xcd_barrier(xbar); } while (0)
    if (IN(0)) { phase0(P, lds); __syncthreads(); }
    if (IN(0) && IN(1)) gemv_wait(P);
    if (IN(1)) norm_mod_phase<1>(P);
    SEAM(1);
    if (IN(2)) { pg8::Gemm g{(const bf16*)(ws + WS_H), (const bf16*)(ws + WS_WIN), MTOK, DIN, DM, LD2}; pg8::StaticOrder S; S.init(MTOK, DIN, DM, G, (int)blockIdx.x);
        pg8::EpiProj E{(bf16*)(ws + WS_PROJ), DIN};
        pg8::gemm_phase<pg8::EpiProj, pg8::StaticOrder, true, true>(lds, g, S, E); }
    SEAM(2);
    if (IN(3)) { rg_phase1(P, lds); if (IN(4)) head_publish(P); sgu_phase(P, lds); }
    if (IN(3) && IN(4)) head_wait(P);
    if (IN(4)) rg_phase2(P, lds);
    SEAM(4);
    if (IN(5)) { pg8::Gemm g{(const bf16*)(ws + WS_MIX), (const bf16*)(ws + WS_WOUT), MTOK, DM, DM, LD2}; pg8::SplitOrder S; S.init(DM, G, (int)blockIdx.x);
        pg8::EpiDelta E{(bf16*)(ws + WS_D1), (bf16*)(ws + WS_PART), (const float*)(ws + WS_MOD) + 2 * DM};
        pg8::gemm_phase<pg8::EpiDelta, pg8::SplitOrder, true, true>(lds, g, S, E); }
    SEAM(5);
    if (IN(6)) norm_mod_phase<2>(P);
    SEAM(6);
    if (IN(7)) { pg8::Gemm g{(const bf16*)(ws + WS_H), (const bf16*)(ws + WS_WFF1), MTOK, DFF, DM, LD2}; pg8::StaticOrder S; S.init(MTOK, DFF, DM, G, (int)blockIdx.x);
        pg8::EpiRelu2 E{(bf16*)(ws + WS_F), LD8};
        pg8::gemm_phase<pg8::EpiRelu2, pg8::StaticOrder, false, true>(lds, g, S, E); }
    SEAM(7);
    if (IN(8)) { pg8::Gemm g{(const bf16*)(ws + WS_F), (const bf16*)(ws + WS_WFF2), MTOK, DM, DFF, LD8}; pg8::SplitOrder S; S.init(DFF, G, (int)blockIdx.x);
        pg8::EpiDelta E{(bf16*)(ws + WS_D2), (bf16*)(ws + WS_PART), (const float*)(ws + WS_MOD) + 5 * DM};
        pg8::gemm_phase<pg8::EpiDelta, pg8::SplitOrder, true, true>(lds, g, S, E); }
    SEAM(8);
    if (IN(9)) final_norm_phase(P, P.out);
#undef IN
#undef SEAM
}

extern "C" void kernel_launch(void* const* d_in, const int* in_sizes, int n_in, void* d_out, int out_size, void* d_ws, size_t ws_size, hipStream_t stream) {
    static int grid = 0;
    if (grid == 0) {
        if (n_in != 23 || ws_size < WS_END) { fprintf(stderr, "kernel_launch: unexpected n_in %d / ws_size %zu\n", n_in, ws_size); grid = -1; return; }
        int dev = 0, cus = 0, per_cu = 0;
        (void)hipGetDevice(&dev); (void)hipDeviceGetAttribute(&cus, hipDeviceAttributeMultiprocessorCount, dev);
        if (hipFuncSetAttribute((const void*)mk_fwd, hipFuncAttributeMaxDynamicSharedMemorySize, LDS_BYTES) != hipSuccess) { fprintf(stderr, "kernel_launch: hipFuncSetAttribute failed\n"); grid = -1; return; }
        if (hipOccupancyMaxActiveBlocksPerMultiprocessor(&per_cu, (const void*)mk_fwd, NTHR, LDS_BYTES) != hipSuccess || per_cu < 1) fprintf(stderr, "kernel_launch: occupancy query says %d\n", per_cu);
        (void)hipGetLastError();
        grid = cus > 0 ? cus : 256;
        if (grid > 256) grid = 256;
        grid &= ~7;
    }
    if (grid < 0) return;
    Params p{};
    for (int i = 0; i < 23; ++i) p.in[i] = (const float*)d_in[i];
    p.out = (float*)d_out; p.ws = (unsigned char*)d_ws;
    p.ph_lo = 0; p.ph_hi = N_PHASES;
    if (hipMemsetAsync(d_ws, 0, 16384, stream) != hipSuccess) { fprintf(stderr, "kernel_launch: memset of the barrier words failed\n"); return; }
    void* args[] = {&p};
    hipError_t e = hipLaunchCooperativeKernel((const void*)mk_fwd, dim3(grid), dim3(NTHR), args, LDS_BYTES, stream);
    if (e != hipSuccess) fprintf(stderr, "cooperative launch failed: %s (grid %d)\n", hipGetErrorString(e), grid);
}
```
